# Optimizing an MI355X kernel written in HIP

```python
import jax, jax.numpy as jnp
from jax import lax
import numpy as np

D_MODEL = 1024
BATCH = 8
SEQ = 8192
DEPTH = 1

D_MIX = D_MODEL
D_MLSTM = D_MIX // 2
D_MOBA = D_MIX - D_MLSTM
MLSTM_HEADS = 4
MLSTM_HEAD_DIM = D_MLSTM // MLSTM_HEADS
MLSTM_CHUNK = 64
CONV_WIDTH = 4
MOBA_HEADS = 8
MOBA_HEAD_DIM = D_MOBA // MOBA_HEADS
MOBA_BLOCK = 256
MOBA_TOPK = 3
MOBA_Q_CHUNK = 32
N_GROUPS = 4
EXPERTS_PER_GROUP = 8
N_EXPERTS = N_GROUPS * EXPERTS_PER_GROUP
EXPERT_TOPK = 2
D_EXPERT = 512
MOE_ROW_BLOCK = 256
EPS = 1e-6
IN_COLS = 4 * D_MLSTM + 2 * MLSTM_HEADS + 3 * D_MOBA

kernel_name = 'hymba_mlstm_moba_hmoe_adaln'


def rms_norm(x, g):
    xf = x.astype(jnp.float32)
    y = xf * lax.rsqrt(jnp.mean(xf * xf, axis=-1, keepdims=True) + EPS)
    return (y * g.astype(jnp.float32)).astype(x.dtype)


def split_heads(a, n_heads):
    b, s, _ = a.shape
    return a.reshape(b, s, n_heads, -1).transpose(0, 2, 1, 3)


def merge_heads(a):
    b, h, s, d = a.shape
    return a.transpose(0, 2, 1, 3).reshape(b, s, h * d)


def causal_depthwise_conv(x, w, b):
    s = x.shape[1]
    xp = jnp.pad(x, ((0, 0), (CONV_WIDTH - 1, 0), (0, 0)))
    y = b
    for j in range(CONV_WIDTH):
        y = y + w[j] * xp[:, j:j + s]
    return y


def mlstm_chunkwise(q, k, v, i_pre, f_pre):
    b, h, s, d = q.shape
    dv = v.shape[-1]
    nc = s // MLSTM_CHUNK
    out_dtype = v.dtype
    qf = q.astype(jnp.float32) * (d ** -0.5)
    kf = k.astype(jnp.float32)
    vf = v.astype(jnp.float32)
    log_i = i_pre.astype(jnp.float32)
    log_f = jax.nn.log_sigmoid(f_pre.astype(jnp.float32))

    def to_chunks(a):
        a = a.reshape(b, h, nc, MLSTM_CHUNK, *a.shape[3:])
        return jnp.moveaxis(a, 2, 0)

    causal = jnp.tril(jnp.ones((MLSTM_CHUNK, MLSTM_CHUNK), dtype=bool))

    def step(carry, inp):
        C, n, m = carry
        qt, kt, vt, it, ft = inp
        cum_f = jnp.cumsum(ft, axis=-1)
        cum_last = cum_f[..., -1]
        dmat = cum_f[..., :, None] - cum_f[..., None, :] + it[..., None, :]
        dmat = jnp.where(causal, dmat, -jnp.inf)
        inter = cum_f + m[..., None]
        m_t = jnp.maximum(inter, jnp.max(dmat, axis=-1))
        w_inter = jnp.exp(inter - m_t)
        sc = jnp.einsum('bhtd,bhsd->bhts', qt, kt) * jnp.exp(dmat - m_t[..., None])
        num = w_inter[..., None] * jnp.einsum('bhtd,bhde->bhte', qt, C) + jnp.einsum('bhts,bhse->bhte', sc, vt)
        den = w_inter * jnp.einsum('bhtd,bhd->bht', qt, n) + jnp.sum(sc, axis=-1)
        h_t = num / jnp.maximum(jnp.abs(den), jnp.exp(-m_t))[..., None]
        g_end = cum_last[..., None] - cum_f + it
        m_new = jnp.maximum(cum_last + m, jnp.max(g_end, axis=-1))
        w_old = jnp.exp(cum_last + m - m_new)
        w_new = jnp.exp(g_end - m_new[..., None])
        C_new = w_old[..., None, None] * C + jnp.einsum('bhs,bhsd,bhse->bhde', w_new, kt, vt)
        n_new = w_old[..., None] * n + jnp.einsum('bhs,bhsd->bhd', w_new, kt)
        return (C_new, n_new, m_new), h_t

    init = (jnp.zeros((b, h, d, dv), jnp.float32), jnp.zeros((b, h, d), jnp.float32),
            jnp.zeros((b, h), jnp.float32))
    _, hs = lax.scan(step, init, (to_chunks(qf), to_chunks(kf), to_chunks(vf),
                                  to_chunks(log_i), to_chunks(log_f)))
    return jnp.moveaxis(hs, 0, 2).reshape(b, h, s, dv).astype(out_dtype)


def moba_attention(q, k, v):
    b, h, s, d = q.shape
    nb = -(-s // MOBA_BLOCK)
    pad = nb * MOBA_BLOCK - s
    kp = jnp.pad(k.astype(jnp.float32), ((0, 0), (0, 0), (0, pad), (0, 0)))
    vp = jnp.pad(v.astype(jnp.float32), ((0, 0), (0, 0), (0, pad), (0, 0)))
    kb = kp.reshape(b, h, nb, MOBA_BLOCK, d)
    vb = vp.reshape(b, h, nb, MOBA_BLOCK, d)
    k_mean = jnp.mean(kb, axis=3)
    scale = d ** -0.5
    n_sel = min(MOBA_TOPK, nb - 1)
    bi = jnp.arange(b)[:, None, None, None]
    hi = jnp.arange(h)[None, :, None, None]
    blk_ids = jnp.arange(nb)

    def chunk(ci):
        t0 = ci * MOBA_Q_CHUNK
        qc = lax.dynamic_slice_in_dim(q, t0, MOBA_Q_CHUNK, axis=2).astype(jnp.float32)
        q_pos = t0 + jnp.arange(MOBA_Q_CHUNK)
        own = t0 // MOBA_BLOCK
        k_own = lax.dynamic_index_in_dim(kb, own, axis=2, keepdims=False)
        v_own = lax.dynamic_index_in_dim(vb, own, axis=2, keepdims=False)
        own_pos = own * MOBA_BLOCK + jnp.arange(MOBA_BLOCK)
        s_own = jnp.einsum('bhqd,bhkd->bhqk', qc, k_own) * scale
        s_own = jnp.where(own_pos[None, :] <= q_pos[:, None], s_own, -jnp.inf)
        if n_sel > 0:
            gate = jnp.einsum('bhqd,bhnd->bhqn', qc, k_mean)
            gate = jnp.where(blk_ids < own, gate, -jnp.inf)
            _, sel = lax.top_k(gate, n_sel)
            valid = sel < own
            k_sel = kb[bi, hi, sel]
            v_sel = vb[bi, hi, sel]
            s_sel = jnp.einsum('bhqd,bhqskd->bhqsk', qc, k_sel) * scale
            s_sel = jnp.where(valid[..., None], s_sel, -jnp.inf)
            p = jax.nn.softmax(jnp.concatenate(
                [s_sel.reshape(b, h, MOBA_Q_CHUNK, n_sel * MOBA_BLOCK), s_own], axis=-1), axis=-1)
            p_sel = p[..., :n_sel * MOBA_BLOCK].reshape(b, h, MOBA_Q_CHUNK, n_sel, MOBA_BLOCK)
            p_own = p[..., n_sel * MOBA_BLOCK:]
            return (jnp.einsum('bhqsk,bhqskd->bhqd', p_sel, v_sel)
                    + jnp.einsum('bhqk,bhkd->bhqd', p_own, v_own))
        p_own = jax.nn.softmax(s_own, axis=-1)
        return jnp.einsum('bhqk,bhkd->bhqd', p_own, v_own)

    outs = lax.map(chunk, jnp.arange(s // MOBA_Q_CHUNK))
    return jnp.moveaxis(outs, 0, 2).reshape(b, h, s, d).astype(q.dtype)


def hierarchical_moe(hx, w_rg, b_rg, w_re, b_re, w_gate, w_up, w_down):
    b, s, dm = hx.shape
    t = b * s
    xt = hx.reshape(t, dm)
    g_prob = jax.nn.softmax((xt @ w_rg).astype(jnp.float32) + b_rg, axis=-1)
    g_w, g_idx = lax.top_k(g_prob, 1)
    e_logits = ((xt @ w_re).astype(jnp.float32) + b_re).reshape(t, N_GROUPS, EXPERTS_PER_GROUP)
    e_logits = jnp.take_along_axis(e_logits, g_idx[:, :, None], axis=1)[:, 0]
    e_top, e_loc = lax.top_k(e_logits, EXPERT_TOPK)
    e_w = jax.nn.softmax(e_top, axis=-1) * g_w
    e_id = g_idx * EXPERTS_PER_GROUP + e_loc

    n_assign = t * EXPERT_TOPK
    flat_e = e_id.reshape(n_assign)
    flat_tok = jnp.repeat(jnp.arange(t), EXPERT_TOPK)
    flat_w = e_w.reshape(n_assign)
    order = jnp.argsort(flat_e)
    se, stok, sw = flat_e[order], flat_tok[order], flat_w[order]
    counts = jnp.zeros((N_EXPERTS,), jnp.int32).at[flat_e].add(1)
    starts = jnp.cumsum(counts) - counts
    padded = (counts + MOE_ROW_BLOCK - 1) // MOE_ROW_BLOCK * MOE_ROW_BLOCK
    pad_ends = jnp.cumsum(padded)
    pad_starts = pad_ends - padded
    dest = pad_starts[se] + (jnp.arange(n_assign) - starts[se])
    n_blocks = -(-n_assign // MOE_ROW_BLOCK) + N_EXPERTS
    rows = n_blocks * MOE_ROW_BLOCK
    x_pad = jnp.zeros((rows, dm), hx.dtype).at[dest].set(xt[stok])
    blk_expert = jnp.minimum(
        jnp.searchsorted(pad_ends, jnp.arange(n_blocks) * MOE_ROW_BLOCK, side='right'), N_EXPERTS - 1)

    def run_block(args):
        xb, e = args
        return (jax.nn.silu(xb @ w_gate[e]) * (xb @ w_up[e])) @ w_down[e]

    y_pad = lax.map(run_block, (x_pad.reshape(n_blocks, MOE_ROW_BLOCK, dm), blk_expert))
    y_sorted = y_pad.reshape(rows, dm)[dest].astype(jnp.float32)
    out = jnp.zeros((t, dm), jnp.float32).at[stok].add(y_sorted * sw[:, None])
    return out.reshape(b, s, dm).astype(hx.dtype)


def setup_inputs(seed: int = 0) -> dict:
    key = jax.random.key(seed)
    ks = jax.random.split(key, 24)
    f32 = jnp.float32

    def nrm(k, shape, sc):
        return sc * jax.random.normal(k, shape, f32)

    L = DEPTH
    x = nrm(ks[0], (BATCH, SEQ, D_MODEL), 1.0)
    c = nrm(ks[1], (BATCH, D_MODEL), 1.0)
    w_ada = nrm(ks[2], (L, D_MODEL, 6 * D_MODEL), 0.5 * D_MODEL ** -0.5)
    b_ada = nrm(ks[3], (L, 6 * D_MODEL), 0.02)
    g_norm1 = 1.0 + nrm(ks[4], (L, D_MODEL), 0.02)
    w_in = nrm(ks[5], (L, D_MODEL, IN_COLS), D_MODEL ** -0.5)
    w_conv = nrm(ks[6], (L, CONV_WIDTH, 2 * D_MLSTM), CONV_WIDTH ** -0.5)
    b_conv = nrm(ks[7], (L, 2 * D_MLSTM), 0.02)
    b_i = nrm(ks[8], (L, MLSTM_HEADS), 0.1)
    b_f = jnp.linspace(3.0, 6.0, MLSTM_HEADS, dtype=f32) + nrm(ks[9], (L, MLSTM_HEADS), 0.1)
    b_gates = jnp.concatenate([b_i, b_f], axis=-1)
    g_mlstm_head = 1.0 + nrm(ks[10], (L, D_MLSTM), 0.02)
    w_out = nrm(ks[11], (L, D_MIX, D_MODEL), D_MIX ** -0.5)
    g_norm2 = 1.0 + nrm(ks[12], (L, D_MODEL), 0.02)
    w_router_group = nrm(ks[13], (L, D_MODEL, N_GROUPS), D_MODEL ** -0.5)
    b_router_group = nrm(ks[14], (L, N_GROUPS), 0.01)
    w_router_expert = nrm(ks[15], (L, D_MODEL, N_EXPERTS), D_MODEL ** -0.5)
    b_router_expert = nrm(ks[16], (L, N_EXPERTS), 0.01)
    w_expert_gate = nrm(ks[17], (L, N_EXPERTS, D_MODEL, D_EXPERT), D_MODEL ** -0.5)
    w_expert_up = nrm(ks[18], (L, N_EXPERTS, D_MODEL, D_EXPERT), D_MODEL ** -0.5)
    w_expert_down = nrm(ks[19], (L, N_EXPERTS, D_EXPERT, D_MODEL), D_EXPERT ** -0.5)
    g_final = 1.0 + nrm(ks[20], (D_MODEL,), 0.02)
    return {'x': x, 'c': c, 'w_ada': w_ada, 'b_ada': b_ada, 'g_norm1': g_norm1, 'w_in': w_in,
            'w_conv': w_conv, 'b_conv': b_conv, 'b_gates': b_gates, 'g_mlstm_head': g_mlstm_head,
            'w_out': w_out, 'g_norm2': g_norm2, 'w_router_group': w_router_group,
            'b_router_group': b_router_group, 'w_router_expert': w_router_expert,
            'b_router_expert': b_router_expert, 'w_expert_gate': w_expert_gate,
            'w_expert_up': w_expert_up, 'w_expert_down': w_expert_down, 'g_final': g_final}


def reference(x, c, w_ada, b_ada, g_norm1, w_in, w_conv, b_conv, b_gates, g_mlstm_head,
              w_out, g_norm2, w_router_group, b_router_group, w_router_expert,
              b_router_expert, w_expert_gate, w_expert_up, w_expert_down, g_final):
    split_at = np.cumsum([D_MLSTM, D_MLSTM, D_MLSTM, D_MLSTM, 2 * MLSTM_HEADS, D_MOBA, D_MOBA]).tolist()
    for l in range(DEPTH):
        mod = jax.nn.silu(c) @ w_ada[l] + b_ada[l]
        shift1, scale1, gate1, shift2, scale2, gate2 = [m[:, None, :] for m in jnp.split(mod, 6, axis=-1)]

        hn = rms_norm(x, g_norm1[l]) * (1.0 + scale1) + shift1
        proj = hn @ w_in[l]
        q_m, k_m, v_m, o_m, gates, q_a, k_a, v_a = jnp.split(proj, split_at, axis=-1)

        qk = jax.nn.silu(causal_depthwise_conv(jnp.concatenate([q_m, k_m], axis=-1), w_conv[l], b_conv[l]))
        q_m, k_m = jnp.split(qk, 2, axis=-1)
        gates = gates + b_gates[l]
        i_pre = gates[..., :MLSTM_HEADS].transpose(0, 2, 1)
        f_pre = gates[..., MLSTM_HEADS:].transpose(0, 2, 1)
        h_m = mlstm_chunkwise(split_heads(q_m, MLSTM_HEADS), split_heads(k_m, MLSTM_HEADS),
                              split_heads(v_m, MLSTM_HEADS), i_pre, f_pre)
        h_m = rms_norm(h_m, g_mlstm_head[l].reshape(MLSTM_HEADS, 1, MLSTM_HEAD_DIM))
        h_m = merge_heads(h_m) * jax.nn.sigmoid(o_m)

        h_a = merge_heads(moba_attention(split_heads(q_a, MOBA_HEADS), split_heads(k_a, MOBA_HEADS),
                                         split_heads(v_a, MOBA_HEADS)))

        mix = jnp.concatenate([h_m, h_a], axis=-1) @ w_out[l]
        x = x + gate1 * mix

        hn2 = rms_norm(x, g_norm2[l]) * (1.0 + scale2) + shift2
        ffn = hierarchical_moe(hn2, w_router_group[l], b_router_group[l], w_router_expert[l],
                               b_router_expert[l], w_expert_gate[l], w_expert_up[l], w_expert_down[l])
        x = x + gate2 * ffn
    return rms_norm(x, g_final)
```

```cpp
#include <hip/hip_runtime.h>
#include <cstdio>
#include <cstdint>

#define LAS __attribute__((address_space(3)))
#define GAS __attribute__((address_space(1)))
typedef unsigned short bf16_t;
typedef short bf16x8 __attribute__((ext_vector_type(8)));
typedef short s16x4 __attribute__((ext_vector_type(4)));
typedef float f32x2 __attribute__((ext_vector_type(2)));
typedef float f32x4 __attribute__((ext_vector_type(4)));
typedef float f32x16 __attribute__((ext_vector_type(16)));
typedef int i32x8 __attribute__((ext_vector_type(8)));
typedef int i32x4 __attribute__((ext_vector_type(4)));
typedef short bf16x16 __attribute__((ext_vector_type(16)));
typedef unsigned u32x2 __attribute__((ext_vector_type(2)));
typedef unsigned u32x4 __attribute__((ext_vector_type(4)));
typedef GAS unsigned gu32;

constexpr int NB = 8, SEQ = 8192, DM = 1024, NTOK = NB * SEQ;
constexpr int NPROJ = 3584;
constexpr int NEXP = 32;
constexpr int MOE_ROWS = (NTOK * 2 / 256 + NEXP) * 256;
constexpr float EPS = 1e-6f;
constexpr int NTHREADS = 512, NWAVES = 8;

constexpr size_t MiB = 1u << 20;
constexpr size_t WS_CTL = 0, CTL_ZERO_BYTES = 1 * MiB;
constexpr size_t WS_MOD = 1 * MiB;
constexpr size_t WS_GATES = 2 * MiB;
constexpr size_t WS_BCUM = 4 * MiB;
constexpr size_t WS_AVAL = 5 * MiB;
constexpr size_t WS_SCINFO = 6 * MiB;
constexpr size_t WS_NLOC = 6 * MiB + 65536;
constexpr size_t WS_NST = 14 * MiB;
constexpr size_t WS_SCW = 14 * MiB + 524288;
constexpr size_t WS_POSOF = 15 * MiB;
constexpr size_t WS_KMEAN = 7 * MiB;
constexpr size_t WS_SEL = 8 * MiB;
constexpr size_t WS_EID = 10 * MiB;
constexpr size_t WS_EW = 10 * MiB + 512 * 1024;
constexpr size_t WS_BCNT = 11 * MiB;
constexpr size_t WS_NTILES = 11 * MiB + 32768;
constexpr size_t WS_TILEE = 11 * MiB + 65536;
constexpr size_t WS_ROWTOK = 12 * MiB;
constexpr size_t WS_ROWW = 13 * MiB;
constexpr size_t WS_HN2 = 122 * MiB;
constexpr size_t WS_X1B = 218 * MiB;
constexpr size_t WS_W1T = 16 * MiB;
constexpr size_t WS_WOT = 23 * MiB;
constexpr size_t WS_WGU = 26 * MiB;
constexpr size_t WS_WD = 90 * MiB;
constexpr size_t WS_CST = 122 * MiB;
constexpr size_t WS_CLOC = 154 * MiB;
constexpr size_t WS_HN = 218 * MiB;
constexpr size_t WS_QC = 218 * MiB;
constexpr size_t WS_KC = 282 * MiB;
constexpr size_t WS_QA = 346 * MiB;
constexpr size_t WS_VM = 666 * MiB;
constexpr size_t HM_SEC = (size_t)NTOK * 512;
constexpr size_t WS_XS = 346 * MiB;
constexpr size_t WS_HB = 618 * MiB;
constexpr size_t WS_YS = 346 * MiB;
constexpr size_t WS_HCAT = 794 * MiB;
constexpr size_t WS_VTA = 922 * MiB;
constexpr size_t WS_END = 1010 * MiB;
constexpr size_t DO_SLOTS = 0;
constexpr size_t DO_ML = 192 * MiB;

constexpr int LDS_BYTES = 155648;
constexpr int MISC_OFF = 150 * 1024;

__device__ __forceinline__ float bf2f(unsigned u16) { return __uint_as_float(u16 << 16); }
__device__ __forceinline__ unsigned f2bf(float f) { unsigned u = __float_as_uint(f); return (u + 0x7fffu + ((u >> 16) & 1u)) >> 16; }
typedef __bf16 bf16x2_t __attribute__((ext_vector_type(2)));
__device__ __forceinline__ unsigned pk2(float lo, float hi) { const f32x2 v = {lo, hi}; return __builtin_bit_cast(unsigned, __builtin_convertvector(v, bf16x2_t)); }
__device__ __forceinline__ unsigned pk4_fp8(float a, float b, float c, float d) { int v = __builtin_amdgcn_cvt_pk_fp8_f32(a, b, 0, false); v = __builtin_amdgcn_cvt_pk_fp8_f32(c, d, v, true); return (unsigned)v; }
__device__ __forceinline__ float lo16(unsigned w) { return __uint_as_float(w << 16); }
__device__ __forceinline__ float hi16(unsigned w) { return __uint_as_float(w & 0xffff0000u); }
__device__ __forceinline__ void unpack8(const u32x4 v, float* f) {
    f[0] = lo16(v.x); f[1] = hi16(v.x); f[2] = lo16(v.y); f[3] = hi16(v.y); f[4] = lo16(v.z); f[5] = hi16(v.z); f[6] = lo16(v.w); f[7] = hi16(v.w);
}
__device__ __forceinline__ float wave_sum(float v) {
#pragma unroll
    for (int o = 1; o < 64; o <<= 1) v += __shfl_xor(v, o);
    return v;
}
__device__ __forceinline__ float wave_max(float v) {
#pragma unroll
    for (int o = 1; o < 64; o <<= 1) v = fmaxf(v, __shfl_xor(v, o));
    return v;
}
__device__ __forceinline__ float silu_f(float v) { return v * __builtin_amdgcn_rcpf(1.0f + __builtin_amdgcn_exp2f(-1.4426950408889634f * v)); }
__device__ __forceinline__ float fexp(float v) { return __builtin_amdgcn_exp2f(1.4426950408889634f * v); }
__device__ __forceinline__ int fresh_lane() { int l; asm volatile("v_mbcnt_lo_u32_b32 %0, -1, 0\n\tv_mbcnt_hi_u32_b32 %0, -1, %0" : "=v"(l)); return l; }
#define LDS_WAIT() asm volatile("s_waitcnt lgkmcnt(0)" ::: "memory")
#define VM_WAIT() asm volatile("s_waitcnt vmcnt(0)" ::: "memory")

#define XB_TMO      128
#define XB_XCNT(j)  (256  + 64 * (j))
#define XB_XSUB(j)  (1280 + 64 * (j))
#define XB_XGEN(j)  (2304 + 64 * (j))
#define XB_TOP      3328
#define XB_TOPGEN   3392
#define XCD_BAR_WORDS 3456
#define XB_SPIN_CAP (1u << 20)
constexpr int CW_BAR = 4096;

__device__ __forceinline__ unsigned xb_ld(unsigned* p)              { return __hip_atomic_load(p, __ATOMIC_RELAXED, __HIP_MEMORY_SCOPE_AGENT); }
__device__ __forceinline__ unsigned xb_add(unsigned* p, unsigned v) { return __hip_atomic_fetch_add(p, v, __ATOMIC_RELAXED, __HIP_MEMORY_SCOPE_AGENT); }
__device__ __forceinline__ unsigned xb_xcc_id() { return (unsigned)__builtin_amdgcn_s_getreg((3 << 11) | 20) & 0xFu; }
#define XB_SPIN(cond, bar) do { unsigned _sp = 0; while (cond) { __builtin_amdgcn_s_sleep(1); \
    if ((++_sp & 255u) == 0u) { if (xb_ld(&(bar)[XB_TMO])) break; if (_sp > XB_SPIN_CAP) { atomicAdd(&(bar)[XB_TMO], 1u); break; } } } } while (0)

struct XcdBarrier { unsigned* bar; unsigned x; volatile LAS unsigned* st; };

__device__ __forceinline__ XcdBarrier xcd_barrier_post(unsigned* bar, volatile LAS unsigned* st) {
    XcdBarrier b; b.bar = bar; b.x = xb_xcc_id(); b.st = st;
    if (threadIdx.x == 0) (void)xb_add(&bar[XB_XCNT(b.x)], 1u);
    return b;
}
__device__ __forceinline__ void xcd_barrier_complete(unsigned* bar, unsigned x, unsigned& nloc, unsigned& nx) {
    const unsigned G = gridDim.x * gridDim.y * gridDim.z;
    unsigned sum, cnt, mine, sp = 0u;
    for (;;) {
        sum = 0u; cnt = 0u; mine = 0u;
#pragma unroll
        for (unsigned j = 0; j < 16; ++j) { const unsigned c = xb_ld(&bar[XB_XCNT(j)]); sum += c; cnt += (c > 0u) ? 1u : 0u; mine = (j == x) ? c : mine; }
        if (sum == G) break;
        __builtin_amdgcn_s_sleep(1);
        if ((++sp & 255u) == 0u) { if (xb_ld(&bar[XB_TMO])) break; if (sp > XB_SPIN_CAP) { atomicAdd(&bar[XB_TMO], 1u); break; } }
    }
    nloc = mine > 0u ? mine : 1u; nx = cnt > 0u ? cnt : 1u;
}
__device__ __forceinline__ void xcd_barrier(const XcdBarrier& b, bool leader) {
    asm volatile("s_waitcnt vmcnt(0)" ::: "memory");
    __syncthreads();
    if (leader) {
        unsigned* bar = b.bar;
        __builtin_amdgcn_s_waitcnt(0);
        unsigned nloc = b.st[0], nx = b.st[1];
        if (nloc == 0u) { xcd_barrier_complete(bar, b.x, nloc, nx); b.st[0] = nloc; b.st[1] = nx; }
        const unsigned old = xb_add(&bar[XB_XSUB(b.x)], 1u);
        const unsigned gen = old / nloc;
        if (old + 1u == (gen + 1u) * nloc) {
            __builtin_amdgcn_fence(__ATOMIC_RELEASE, "agent");
            asm volatile("s_waitcnt vmcnt(0)" ::: "memory");
            const unsigned og = xb_add(&bar[XB_TOP], 1u);
            const unsigned tg = og / nx;
            if (og + 1u == (tg + 1u) * nx) xb_add(&bar[XB_TOPGEN], 1u);
            else XB_SPIN(xb_ld(&bar[XB_TOPGEN]) == tg, bar);
            __builtin_amdgcn_fence(__ATOMIC_ACQUIRE, "agent");
            xb_add(&bar[XB_XGEN(b.x)], 1u);
            asm volatile("s_waitcnt vmcnt(0)" ::: "memory");
        } else {
            XB_SPIN(xb_ld(&bar[XB_XGEN(b.x)]) == gen, bar);
            __builtin_amdgcn_fence(__ATOMIC_ACQUIRE, "agent");
            asm volatile("s_waitcnt vmcnt(0)" ::: "memory");
        }
    }
    __syncthreads();
}

namespace pg8 {
constexpr int BM = 256, BK = 64, HALF = 128, HTB = HALF * BK * 2, STAGE_BYTES = 8 * HTB, NXCD = 8, WGM = 8;
__device__ __forceinline__ int lds_byte(int r, int c) { const int st = (r >> 4) * 2 + (c >> 5), rr = r & 15, cc = c & 31, ob = rr * 64 + cc * 2; return st * 1024 + (ob ^ (((ob >> 9) & 1) << 5)); }
__device__ __forceinline__ void stage_rc(int b, int& R, int& C) { const int st = b / 1024, sb = b % 1024, swz = sb ^ (((sb >> 9) & 1) << 5); R = (st >> 1) * 16 + swz / 64; C = (st & 1) * 32 + (swz % 64) / 2; }
__device__ __forceinline__ int perm32(int rho) { const int n = rho >> 4, i = rho & 15; return 8 * (i >> 2) + 4 * n + (i & 3); }

struct Unit { int pm, pn; const char* a; const char* b; };

struct DenseOrder {
    int nM, nN, nwg, G, c; const char* A; const char* Bt; size_t tstep;
    __device__ __forceinline__ void init(const void* A_, const void* Bt_, int M, int N, int K, int G_, int c_) { A = (const char*)A_; Bt = (const char*)Bt_; nM = M / BM; nN = N / BM; nwg = nM * nN; G = G_; c = c_; tstep = (size_t)BM * K * 2; }
    __device__ __forceinline__ bool next(int i, Unit& u) const {
        const long L = (long)i * G + c; if (L >= nwg) return false;
        int wgid = (int)L; { const int q = nwg / NXCD, r = nwg % NXCD, xcd = wgid % NXCD, off = wgid / NXCD; wgid = (xcd < r ? xcd * (q + 1) : r * (q + 1) + (xcd - r) * q) + off; }
        const int nig = WGM * nN, gid = wgid / nig, fm = gid * WGM, gsz = (nM - fm) < WGM ? (nM - fm) : WGM;
        u.pm = fm + ((wgid % nig) % gsz); u.pn = (wgid % nig) / gsz; u.a = A + (size_t)u.pm * tstep; u.b = Bt + (size_t)u.pn * tstep; return true;
    }
};
struct RowMajorOrder {
    int nM, nN, G, v; const char* A; const char* Bt; size_t tstep;
    __device__ __forceinline__ void init(const void* A_, const void* Bt_, int M, int N, int K, int G_, int v_) { A = (const char*)A_; Bt = (const char*)Bt_; nM = M / BM; nN = N / BM; G = G_; v = v_; tstep = (size_t)BM * K * 2; }
    __device__ __forceinline__ bool next(int i, Unit& u) const {
        const int pm = v + (i / nN) * G; if (pm >= nM) return false;
        u.pm = pm; u.pn = i % nN; u.a = A + (size_t)u.pm * tstep; u.b = Bt + (size_t)u.pn * tstep; return true;
    }
};
struct MoeOrder {
    const int* tile_e; int nunits, G, vcu; const char* A; const char* Bt; size_t a_tile, b_exp, b_tile;
    __device__ __forceinline__ bool next(int i, Unit& u) const {
        const long L = (long)i * G + vcu; if (L >= nunits) return false;
        const int rt = (int)(L >> 2), pn = (int)(L & 3); const int e = __builtin_amdgcn_readfirstlane(tile_e[rt]);
        u.pm = rt; u.pn = pn; u.a = A + (size_t)rt * a_tile; u.b = Bt + (size_t)e * b_exp + (size_t)pn * b_tile; return true;
    }
};

__device__ __forceinline__ unsigned cvt_pk_bf16(float lo, float hi) { unsigned r; asm volatile("v_cvt_pk_bf16_f32 %0, %1, %2" : "=v"(r) : "v"(lo), "v"(hi)); return r; }

struct EpiBf16 {
    static constexpr bool PERM = true;
    bf16_t* O; int ldc;
    __device__ __forceinline__ void operator()(const f32x4 (&acc)[2][2][4][2], const Unit& u, int wr, int wc, int fr, int fq) const {
        const int row0 = u.pm * BM + wr * 64 + fr; const int col0 = u.pn * BM + wc * 32 + 8 * fq;
#pragma unroll
        for (int ai = 0; ai < 2; ++ai)
#pragma unroll
            for (int m = 0; m < 4; ++m) { bf16_t* rowp = O + (size_t)(row0 + ai * HALF + m * 16) * ldc + col0;
#pragma unroll
                for (int bj = 0; bj < 2; ++bj) { const f32x4 v0 = acc[ai][bj][m][0], v1 = acc[ai][bj][m][1];
                    u32x4 w; w.x = cvt_pk_bf16(v0[0], v0[1]); w.y = cvt_pk_bf16(v0[2], v0[3]); w.z = cvt_pk_bf16(v1[0], v1[1]); w.w = cvt_pk_bf16(v1[2], v1[3]);
                    *(u32x4*)(rowp + bj * HALF) = w; } }
    }
};
struct EpiProj {
    static constexpr bool PERM = true;
    bf16_t* HM; bf16_t* VM;
    __device__ __forceinline__ void operator()(const f32x4 (&acc)[2][2][4][2], const Unit& u, int wr, int wc, int fr, int fq) const {
        const int b = u.pm >> 5, t0 = (u.pm & 31) * BM + wr * 64 + fr;
        bf16_t* base; size_t rstep, bstep;
        if (u.pn >= 4 && u.pn < 8) { const int sec = (u.pn - 4) >> 1, h0 = (u.pn & 1) * 2;
            base = VM + (size_t)sec * ((size_t)NTOK * 512) + ((size_t)(b * 4 + h0) * SEQ + t0) * 128 + wc * 32 + 8 * fq; rstep = 16 * 128; bstep = (size_t)SEQ * 128; }
        else { const int sec = (u.pn < 4) ? 3 + (u.pn >> 1) : (u.pn - 8) >> 1, g0 = (u.pn & 1) * 4 + (wc >> 1);
            base = HM + (size_t)sec * ((size_t)NTOK * 512) + ((size_t)(b * 8 + g0) * SEQ + t0) * 64 + (wc & 1) * 32 + 8 * fq; rstep = 16 * 64; bstep = (size_t)2 * SEQ * 64; }
#pragma unroll
        for (int ai = 0; ai < 2; ++ai)
#pragma unroll
            for (int m = 0; m < 4; ++m) { bf16_t* rowp = base + (size_t)(ai * 8 + m) * rstep;
#pragma unroll
                for (int bj = 0; bj < 2; ++bj) { const f32x4 v0 = acc[ai][bj][m][0], v1 = acc[ai][bj][m][1];
                    u32x4 w; w.x = cvt_pk_bf16(v0[0], v0[1]); w.y = cvt_pk_bf16(v0[2], v0[3]); w.z = cvt_pk_bf16(v1[0], v1[1]); w.w = cvt_pk_bf16(v1[2], v1[3]);
                    *(u32x4*)(rowp + bj * bstep) = w; } }
    }
};
struct EpiRes {
    static constexpr bool PERM = true;
    const float* x; bf16_t* out; const float* gate;
    __device__ __forceinline__ void operator()(const f32x4 (&acc)[2][2][4][2], const Unit& u, int wr, int wc, int fr, int fq) const {
        const int col0 = u.pn * BM + wc * 32 + 8 * fq; const float* gp = gate + (size_t)(u.pm >> 5) * 6144 + col0;
        f32x4 gv[2][2];
#pragma unroll
        for (int bj = 0; bj < 2; ++bj)
#pragma unroll
            for (int n = 0; n < 2; ++n) gv[bj][n] = *(const f32x4*)(gp + bj * HALF + n * 4);
#pragma unroll
        for (int ai = 0; ai < 2; ++ai)
#pragma unroll
            for (int m = 0; m < 4; ++m) { const size_t off = (size_t)(u.pm * BM + ai * HALF + wr * 64 + m * 16 + fr) * DM + col0;
#pragma unroll
                for (int bj = 0; bj < 2; ++bj) { const f32x4 x0 = *(const f32x4*)(x + off + bj * HALF), x1 = *(const f32x4*)(x + off + bj * HALF + 4);
                    const f32x4 v0 = x0 + gv[bj][0] * acc[ai][bj][m][0], v1 = x1 + gv[bj][1] * acc[ai][bj][m][1];
                    u32x4 w; w.x = cvt_pk_bf16(v0[0], v0[1]); w.y = cvt_pk_bf16(v0[2], v0[3]); w.z = cvt_pk_bf16(v1[0], v1[1]); w.w = cvt_pk_bf16(v1[2], v1[3]);
                    *(u32x4*)(out + off + bj * HALF) = w; } }
    }
};
struct EpiSwiglu {
    static constexpr bool PERM = true;
    bf16_t* H;
    __device__ __forceinline__ void operator()(const f32x4 (&acc)[2][2][4][2], const Unit& u, int wr, int wc, int fr, int fq) const {
        const int row0 = u.pm * BM + wr * 64 + fr; const int col0 = u.pn * HALF + wc * 32 + 8 * fq;
#pragma unroll
        for (int ai = 0; ai < 2; ++ai)
#pragma unroll
            for (int m = 0; m < 4; ++m) { float h[8];
#pragma unroll
                for (int n = 0; n < 2; ++n)
#pragma unroll
                    for (int j = 0; j < 4; ++j) { const float g = acc[ai][0][m][n][j], up = acc[ai][1][m][n][j]; h[n * 4 + j] = g * __builtin_amdgcn_rcpf(1.0f + __builtin_amdgcn_exp2f(-1.4426950408889634f * g)) * up; }
                u32x4 w; w.x = cvt_pk_bf16(h[0], h[1]); w.y = cvt_pk_bf16(h[2], h[3]); w.z = cvt_pk_bf16(h[4], h[5]); w.w = cvt_pk_bf16(h[6], h[7]);
                *(u32x4*)(H + (size_t)(row0 + ai * HALF + m * 16) * 512 + col0) = w; }
    }
};
struct EpiSwigluF8 {
    static constexpr bool PERM = true;
    unsigned char* H;
    __device__ __forceinline__ void operator()(const f32x4 (&acc)[2][2][4][2], const Unit& u, int wr, int wc, int fr, int fq) const {
        const int row0 = u.pm * BM + wr * 64 + fr; const int col0 = u.pn * HALF + wc * 32 + 8 * fq;
#pragma unroll
        for (int ai = 0; ai < 2; ++ai)
#pragma unroll
            for (int m = 0; m < 4; ++m) { float h[8];
#pragma unroll
                for (int n = 0; n < 2; ++n)
#pragma unroll
                    for (int j = 0; j < 4; ++j) { const float g = acc[ai][0][m][n][j], up = acc[ai][1][m][n][j]; h[n * 4 + j] = g * __builtin_amdgcn_rcpf(1.0f + __builtin_amdgcn_exp2f(-1.4426950408889634f * g)) * up; }
                *(u32x2*)(H + (size_t)(row0 + ai * HALF + m * 16) * 512 + col0) = (u32x2){pk4_fp8(h[0], h[1], h[2], h[3]), pk4_fp8(h[4], h[5], h[6], h[7])}; }
    }
};
struct EpiF8 {
    static constexpr bool PERM = true;
    unsigned char* O; int ldc;
    __device__ __forceinline__ void operator()(const f32x4 (&acc)[2][2][4][2], const Unit& u, int wr, int wc, int fr, int fq) const {
        const int row0 = u.pm * BM + wr * 64 + fr; const int col0 = u.pn * BM + wc * 32 + 8 * fq;
#pragma unroll
        for (int ai = 0; ai < 2; ++ai)
#pragma unroll
            for (int m = 0; m < 4; ++m) { unsigned char* rowp = O + (size_t)(row0 + ai * HALF + m * 16) * ldc + col0;
#pragma unroll
                for (int bj = 0; bj < 2; ++bj) { const f32x4 v0 = acc[ai][bj][m][0], v1 = acc[ai][bj][m][1];
                    *(u32x2*)(rowp + bj * HALF) = (u32x2){pk4_fp8(v0[0], v0[1], v0[2], v0[3]), pk4_fp8(v1[0], v1[1], v1[2], v1[3])}; } }
    }
};
struct EpiScatter {
    static constexpr bool PERM = true;
    bf16_t* Y; const int* rowtok; const float* roww;
    __device__ __forceinline__ void operator()(const f32x4 (&acc)[2][2][4][2], const Unit& u, int wr, int wc, int fr, int fq) const {
        const int row0 = u.pm * BM + wr * 64 + fr; const int col0 = u.pn * BM + wc * 32 + 8 * fq;
#pragma unroll
        for (int ai = 0; ai < 2; ++ai)
#pragma unroll
            for (int m = 0; m < 4; ++m) { const int r = row0 + ai * HALF + m * 16; const int rt = rowtok[r]; const float w = roww[r];
                if (rt >= 0) { bf16_t* rowp = Y + (size_t)rt * DM + col0;
#pragma unroll
                    for (int bj = 0; bj < 2; ++bj) { const f32x4 v0 = acc[ai][bj][m][0] * w, v1 = acc[ai][bj][m][1] * w;
                        u32x4 o; o.x = cvt_pk_bf16(v0[0], v0[1]); o.y = cvt_pk_bf16(v0[2], v0[3]); o.z = cvt_pk_bf16(v1[0], v1[1]); o.w = cvt_pk_bf16(v1[2], v1[3]);
                        *(u32x4*)(rowp + bj * HALF) = o; } } }
    }
};

template <int K, class Epi, class Sched, bool ALIGN_EPI, bool GATHER = false>
__device__ __forceinline__ void gemm_phase(LAS unsigned char* lds, const Sched& S, const Epi& E, int wid, const int* rows = nullptr) {
    const int lane = fresh_lane(), tid = wid * 64 + lane, wr = wid >> 2, wc = wid & 3, fr = lane & 15, fq = lane >> 4;
    constexpr int nt = K / BK;
    unsigned voffA[2][2], voffN[2][2], voffB[2];
    int Rr[2], Cc[2];
#pragma unroll
    for (int i = 0; i < 2; ++i) { int R, C; stage_rc(tid * 16 + i * 8192, R, C); const int Rb = Epi::PERM ? ((R & ~31) + perm32(R & 31)) : R; Rr[i] = R; Cc[i] = C;
        voffA[0][i] = (unsigned)(R * K + C) * 2u; voffA[1][i] = 0u; voffB[i] = (unsigned)(Rb * K + C) * 2u; }
    constexpr size_t kstep = (size_t)(BK * 2);
    constexpr size_t hstep = (size_t)HALF * K * 2;
    const unsigned ldsw = (unsigned)wid * 1024u;
    const int aoff = lds_byte(wr * 64 + fr, fq * 8), boff = lds_byte(wc * 32 + fr, fq * 8);
#define PG8_SA(b, h) (((b) * 2 + (h)) * HTB)
#define PG8_SB(b, h) ((4 + (b) * 2 + (h)) * HTB)
#define PG8_STAGE(bufoff, gbase, voff) do { _Pragma("unroll") for (int _i = 0; _i < 2; ++_i) \
        __builtin_amdgcn_global_load_lds((const unsigned*)((const char*)(gbase) + (voff)[_i]), (LAS unsigned*)(lds + (bufoff) + ldsw + _i * 8192), 16, 0, 0); } while (0)
#define PG8_STAGE_A1(bufoff, gbase, voff2) do { _Pragma("unroll") for (int _i = 0; _i < 2; ++_i) \
        __builtin_amdgcn_global_load_lds((const unsigned*)((const char*)(gbase) + (GATHER ? (size_t)0 : hstep) + (GATHER ? (voff2)[1][_i] : (voff2)[0][_i])), (LAS unsigned*)(lds + (bufoff) + ldsw + _i * 8192), 16, 0, 0); } while (0)
#define PG8_LDA(dst, b, h) do { _Pragma("unroll") for (int m = 0; m < 4; ++m) _Pragma("unroll") for (int k = 0; k < 2; ++k) dst[m][k] = *(const LAS bf16x8*)(lds + PG8_SA(b, h) + aoff + m * 2048 + k * 1024); } while (0)
#define PG8_LDB(dst, b, h) do { _Pragma("unroll") for (int n = 0; n < 2; ++n) _Pragma("unroll") for (int k = 0; k < 2; ++k) dst[n][k] = *(const LAS bf16x8*)(lds + PG8_SB(b, h) + boff + n * 2048 + k * 1024); } while (0)
#define PG8_MMA(ai, bj, At, Bt) do { __builtin_amdgcn_s_setprio(1); _Pragma("unroll") for (int m = 0; m < 4; ++m) _Pragma("unroll") for (int n = 0; n < 2; ++n) _Pragma("unroll") for (int k = 0; k < 2; ++k) \
        acc[ai][bj][m][n] = __builtin_amdgcn_mfma_f32_16x16x32_bf16(Bt[n][k], At[m][k], acc[ai][bj][m][n], 0, 0, 0); __builtin_amdgcn_s_setprio(0); } while (0)
#define PG8_WAIT_V(n) asm volatile("s_waitcnt vmcnt(" #n ")" ::: "memory")
#define PG8_WAIT_L(n) asm volatile("s_waitcnt lgkmcnt(" #n ")" ::: "memory")
#define PG8_BAR __builtin_amdgcn_s_barrier()
#define PG8_SCHED __builtin_amdgcn_sched_barrier(0)
    Unit cur, nxt; int ui = 0;
    if (!S.next(0, cur)) return;
    f32x4 acc[2][2][4][2];
#pragma unroll
    for (int a = 0; a < 2; ++a)
#pragma unroll
        for (int b = 0; b < 2; ++b)
#pragma unroll
            for (int m = 0; m < 4; ++m)
#pragma unroll
                for (int n = 0; n < 2; ++n) acc[a][b][m][n] = (f32x4){0.f, 0.f, 0.f, 0.f};
    bf16x8 At[4][2], B0[2][2], B1[2][2];
    const char* cA = cur.a; const char* cB = cur.b;
    if constexpr (GATHER) {
#pragma unroll
        for (int h = 0; h < 2; ++h)
#pragma unroll
            for (int i = 0; i < 2; ++i) voffA[h][i] = (unsigned)rows[cur.pm * BM + h * HALF + Rr[i]] * (unsigned)(K * 2) + (unsigned)Cc[i] * 2u; }
    PG8_STAGE(PG8_SB(0, 0), cB, voffB); PG8_STAGE(PG8_SB(0, 1), cB + hstep, voffB); PG8_STAGE(PG8_SA(0, 0), cA, voffA[0]); PG8_STAGE_A1(PG8_SA(0, 1), cA, voffA);
    if (wr == 1) PG8_BAR;
    PG8_WAIT_V(2); PG8_BAR;
    PG8_STAGE(PG8_SB(1, 0), cB + kstep, voffB); PG8_STAGE(PG8_SA(1, 0), cA + kstep, voffA[0]); PG8_STAGE(PG8_SB(1, 1), cB + hstep + kstep, voffB);
    PG8_WAIT_V(6); PG8_BAR;
    for (;;) {
        const bool has_next = S.next(ui + 1, nxt);
        const char* nA = has_next ? nxt.a : cA; const char* nB = has_next ? nxt.b : cB;
        if constexpr (GATHER) {
            const int npm = has_next ? nxt.pm : cur.pm;
#pragma unroll
            for (int h = 0; h < 2; ++h)
#pragma unroll
                for (int i = 0; i < 2; ++i) voffN[h][i] = (unsigned)rows[npm * BM + h * HALF + Rr[i]] * (unsigned)(K * 2) + (unsigned)Cc[i] * 2u; }
        for (int t = 0; t < nt; t += 2) {
            const bool last = (t == nt - 2);
            unsigned vs[2][2];
#pragma unroll
            for (int h = 0; h < 2; ++h)
#pragma unroll
                for (int i = 0; i < 2; ++i) vs[h][i] = (GATHER && last) ? voffN[h][i] : voffA[h][i];
            const char* a1 = cA + (size_t)(t + 1) * kstep;
            const char* a2 = last ? nA : cA + (size_t)(t + 2) * kstep; const char* b2 = last ? nB : cB + (size_t)(t + 2) * kstep;
            const char* a3 = a2 + kstep; const char* b3 = b2 + kstep;
            PG8_LDB(B0, 0, 0); PG8_LDB(B1, 0, 1); PG8_SCHED; PG8_LDA(At, 0, 0); PG8_STAGE_A1(PG8_SA(1, 1), a1, voffA);
            PG8_WAIT_V(8); PG8_WAIT_L(0); PG8_BAR; PG8_MMA(0, 0, At, B0); PG8_MMA(0, 1, At, B1); PG8_BAR; PG8_SCHED;
            PG8_LDA(At, 0, 1); PG8_STAGE(PG8_SB(0, 0), b2, voffB); PG8_STAGE(PG8_SB(0, 1), b2 + hstep, voffB); PG8_STAGE(PG8_SA(0, 0), a2, vs[0]);
            PG8_WAIT_V(8); PG8_WAIT_L(0); PG8_BAR; PG8_MMA(1, 0, At, B0); PG8_MMA(1, 1, At, B1); PG8_BAR; PG8_SCHED;
            PG8_LDB(B0, 1, 0); PG8_LDB(B1, 1, 1); PG8_SCHED; PG8_LDA(At, 1, 0); PG8_STAGE_A1(PG8_SA(0, 1), a2, vs);
            PG8_WAIT_V(8); PG8_WAIT_L(0); PG8_BAR; PG8_MMA(0, 0, At, B0); PG8_MMA(0, 1, At, B1); PG8_BAR; PG8_SCHED;
            PG8_LDA(At, 1, 1); PG8_STAGE(PG8_SB(1, 0), b3, voffB); PG8_STAGE(PG8_SB(1, 1), b3 + hstep, voffB); PG8_STAGE(PG8_SA(1, 0), a3, vs[0]);
            PG8_WAIT_V(8); PG8_WAIT_L(0); PG8_BAR; PG8_MMA(1, 0, At, B0); PG8_MMA(1, 1, At, B1); PG8_BAR; PG8_SCHED;
        }
        if constexpr (ALIGN_EPI) { if (wr == 0) PG8_BAR; }
        E(acc, cur, wr, wc, fr, fq);
        if (!has_next) break;
#pragma unroll
        for (int a = 0; a < 2; ++a)
#pragma unroll
            for (int b = 0; b < 2; ++b)
#pragma unroll
                for (int m = 0; m < 4; ++m)
#pragma unroll
                    for (int n = 0; n < 2; ++n) acc[a][b][m][n] = (f32x4){0.f, 0.f, 0.f, 0.f};
        cur = nxt; cA = nA; cB = nB; ++ui;
        if constexpr (GATHER) {
#pragma unroll
            for (int h = 0; h < 2; ++h)
#pragma unroll
                for (int i = 0; i < 2; ++i) voffA[h][i] = voffN[h][i]; }
        if constexpr (ALIGN_EPI) { if (wr == 1) PG8_BAR; }
    }
    PG8_WAIT_V(0);
    if constexpr (!ALIGN_EPI) { if (wr == 0) PG8_BAR; }
    PG8_BAR;
#undef PG8_SA
#undef PG8_SB
#undef PG8_STAGE
#undef PG8_STAGE_A1
#undef PG8_LDA
#undef PG8_LDB
#undef PG8_MMA
#undef PG8_WAIT_V
#undef PG8_WAIT_L
#undef PG8_BAR
#undef PG8_SCHED
}
template <int K, class Epi, class Sched, bool ALIGN_EPI, bool GATHER, int SCALE_W>
__device__ __forceinline__ void gemm_phase_fp8(LAS unsigned char* lds, const Sched& S, const Epi& E, int wid, const int* rows) {
    const int lane = fresh_lane(), tid = wid * 64 + lane, wr = wid >> 2, wc = wid & 3, fr = lane & 15, fq = lane >> 4;
    constexpr int nt = K / 128;
    unsigned voffA[2][2], voffN[2][2], voffB[2];
#pragma unroll
    for (int i = 0; i < 2; ++i) { int R, C; stage_rc(tid * 16 + i * 8192, R, C); const int Rb = Epi::PERM ? ((R & ~31) + perm32(R & 31)) : R;
        voffA[0][i] = (unsigned)(R * K + C * 2); voffA[1][i] = 0u; voffB[i] = (unsigned)(Rb * K + C * 2); }
    constexpr size_t kstep = (size_t)(BK * 2);
    constexpr size_t hstep = (size_t)HALF * K;
    const unsigned ldsw = (unsigned)wid * 1024u;
    const int aoff = lds_byte(wr * 64 + fr, fq * 16), boff = lds_byte(wc * 32 + fr, fq * 16);
#define PG8_SA(b, h) (((b) * 2 + (h)) * HTB)
#define PG8_SB(b, h) ((4 + (b) * 2 + (h)) * HTB)
#define PG8_STAGE(bufoff, gbase, voff) do { _Pragma("unroll") for (int _i = 0; _i < 2; ++_i) \
        __builtin_amdgcn_global_load_lds((const unsigned*)((const char*)(gbase) + (voff)[_i]), (LAS unsigned*)(lds + (bufoff) + ldsw + _i * 8192), 16, 0, 0); } while (0)
#define PG8_STAGE_A1(bufoff, gbase, voff2) do { _Pragma("unroll") for (int _i = 0; _i < 2; ++_i) \
        __builtin_amdgcn_global_load_lds((const unsigned*)((const char*)(gbase) + (GATHER ? (size_t)0 : hstep) + (GATHER ? (voff2)[1][_i] : (voff2)[0][_i])), (LAS unsigned*)(lds + (bufoff) + ldsw + _i * 8192), 16, 0, 0); } while (0)
#define PG8_LDA(dst, b, h) do { _Pragma("unroll") for (int m = 0; m < 4; ++m) { const i32x4 lo_ = *(const LAS i32x4*)(lds + PG8_SA(b, h) + aoff + m * 2048), hi_ = *(const LAS i32x4*)(lds + PG8_SA(b, h) + (aoff ^ 16) + m * 2048); dst[m] = __builtin_shufflevector(lo_, hi_, 0, 1, 2, 3, 4, 5, 6, 7); } } while (0)
#define PG8_LDB(dst, b, h) do { _Pragma("unroll") for (int n = 0; n < 2; ++n) { const i32x4 lo_ = *(const LAS i32x4*)(lds + PG8_SB(b, h) + boff + n * 2048), hi_ = *(const LAS i32x4*)(lds + PG8_SB(b, h) + (boff ^ 16) + n * 2048); dst[n] = __builtin_shufflevector(lo_, hi_, 0, 1, 2, 3, 4, 5, 6, 7); } } while (0)
#define PG8_F8(x) (x)
#define PG8_MMA(ai, bj, At, Bt) do { __builtin_amdgcn_s_setprio(1); _Pragma("unroll") for (int m = 0; m < 4; ++m) _Pragma("unroll") for (int n = 0; n < 2; ++n) \
        acc[ai][bj][m][n] = __builtin_amdgcn_mfma_scale_f32_16x16x128_f8f6f4(PG8_F8(Bt[n]), PG8_F8(At[m]), acc[ai][bj][m][n], 0, 0, 0, SCALE_W, 0, 127); __builtin_amdgcn_s_setprio(0); \
        _Pragma("unroll") for (int m = 0; m < 4; ++m) _Pragma("unroll") for (int n = 0; n < 2; ++n) asm volatile("" : "+v"(acc[ai][bj][m][n])); } while (0)
#define PG8_WAIT_V(n) asm volatile("s_waitcnt vmcnt(" #n ")" ::: "memory")
#define PG8_WAIT_L(n) asm volatile("s_waitcnt lgkmcnt(" #n ")" ::: "memory")
#define PG8_BAR __builtin_amdgcn_s_barrier()
#define PG8_SCHED __builtin_amdgcn_sched_barrier(0)
    Unit cur, nxt; int ui = 0;
    if (!S.next(0, cur)) return;
    f32x4 acc[2][2][4][2];
#pragma unroll
    for (int a = 0; a < 2; ++a)
#pragma unroll
        for (int b = 0; b < 2; ++b)
#pragma unroll
            for (int m = 0; m < 4; ++m)
#pragma unroll
                for (int n = 0; n < 2; ++n) acc[a][b][m][n] = (f32x4){0.f, 0.f, 0.f, 0.f};
    i32x8 At[4], B0[2], B1[2];
    const char* cA = cur.a; const char* cB = cur.b;
    if constexpr (GATHER) {
#pragma unroll
        for (int h = 0; h < 2; ++h)
#pragma unroll
            for (int i = 0; i < 2; ++i) { int R, C; stage_rc(tid * 16 + i * 8192, R, C); voffA[h][i] = (unsigned)rows[cur.pm * BM + h * HALF + R] * (unsigned)K + (unsigned)C * 2u; } }
    PG8_STAGE(PG8_SB(0, 0), cB, voffB); PG8_STAGE(PG8_SB(0, 1), cB + hstep, voffB); PG8_STAGE(PG8_SA(0, 0), cA, voffA[0]); PG8_STAGE_A1(PG8_SA(0, 1), cA, voffA);
    if (wr == 1) PG8_BAR;
    PG8_WAIT_V(2); PG8_BAR;
    PG8_STAGE(PG8_SB(1, 0), cB + kstep, voffB); PG8_STAGE(PG8_SA(1, 0), cA + kstep, voffA[0]); PG8_STAGE(PG8_SB(1, 1), cB + hstep + kstep, voffB);
    PG8_WAIT_V(6); PG8_BAR;
    for (;;) {
        const bool has_next = S.next(ui + 1, nxt);
        const char* nA = has_next ? nxt.a : cA; const char* nB = has_next ? nxt.b : cB;
        if constexpr (GATHER) {
            const int npm = has_next ? nxt.pm : cur.pm;
#pragma unroll
            for (int h = 0; h < 2; ++h)
#pragma unroll
                for (int i = 0; i < 2; ++i) { int R, C; stage_rc(tid * 16 + i * 8192, R, C); voffN[h][i] = (unsigned)rows[npm * BM + h * HALF + R] * (unsigned)K + (unsigned)C * 2u; } }
#pragma unroll 1
        for (int t = 0; t < nt; t += 2) {
            const bool last = (t == nt - 2);
            unsigned vs[2][2];
#pragma unroll
            for (int h = 0; h < 2; ++h)
#pragma unroll
                for (int i = 0; i < 2; ++i) { if constexpr (GATHER) vs[h][i] = last ? voffN[h][i] : voffA[h][i]; else vs[h][i] = voffA[h][i]; }
            const char* a1 = cA + (size_t)(t + 1) * kstep;
            const char* a2 = last ? nA : cA + (size_t)(t + 2) * kstep; const char* b2 = last ? nB : cB + (size_t)(t + 2) * kstep;
            const char* a3 = a2 + kstep; const char* b3 = b2 + kstep;
            PG8_LDB(B0, 0, 0); PG8_LDB(B1, 0, 1); PG8_SCHED; PG8_LDA(At, 0, 0); PG8_STAGE_A1(PG8_SA(1, 1), a1, voffA);
            PG8_WAIT_V(8); PG8_WAIT_L(0); PG8_BAR; PG8_MMA(0, 0, At, B0); PG8_MMA(0, 1, At, B1); PG8_BAR; PG8_SCHED;
            PG8_LDA(At, 0, 1); PG8_STAGE(PG8_SB(0, 0), b2, voffB); PG8_STAGE(PG8_SB(0, 1), b2 + hstep, voffB); PG8_STAGE(PG8_SA(0, 0), a2, vs[0]);
            PG8_WAIT_V(8); PG8_WAIT_L(0); PG8_BAR; PG8_MMA(1, 0, At, B0); PG8_MMA(1, 1, At, B1); PG8_BAR; PG8_SCHED;
            PG8_LDB(B0, 1, 0); PG8_LDB(B1, 1, 1); PG8_SCHED; PG8_LDA(At, 1, 0); PG8_STAGE_A1(PG8_SA(0, 1), a2, vs);
            PG8_WAIT_V(8); PG8_WAIT_L(0); PG8_BAR; PG8_MMA(0, 0, At, B0); PG8_MMA(0, 1, At, B1); PG8_BAR; PG8_SCHED;
            PG8_LDA(At, 1, 1); PG8_STAGE(PG8_SB(1, 0), b3, voffB); PG8_STAGE(PG8_SB(1, 1), b3 + hstep, voffB); PG8_STAGE(PG8_SA(1, 0), a3, vs[0]);
            PG8_WAIT_V(8); PG8_WAIT_L(0); PG8_BAR; PG8_MMA(1, 0, At, B0); PG8_MMA(1, 1, At, B1); PG8_BAR; PG8_SCHED;
        }
        if constexpr (ALIGN_EPI) { if (wr == 0) PG8_BAR; }
        E(acc, cur, wr, wc, fr, fq);
        if (!has_next) break;
#pragma unroll
        for (int a = 0; a < 2; ++a)
#pragma unroll
            for (int b = 0; b < 2; ++b)
#pragma unroll
                for (int m = 0; m < 4; ++m)
#pragma unroll
                    for (int n = 0; n < 2; ++n) acc[a][b][m][n] = (f32x4){0.f, 0.f, 0.f, 0.f};
        cur = nxt; cA = nA; cB = nB; ++ui;
        if constexpr (GATHER) {
#pragma unroll
            for (int h = 0; h < 2; ++h)
#pragma unroll
                for (int i = 0; i < 2; ++i) voffA[h][i] = voffN[h][i]; }
        if constexpr (ALIGN_EPI) { if (wr == 1) PG8_BAR; }
    }
    PG8_WAIT_V(0);
    if constexpr (!ALIGN_EPI) { if (wr == 0) PG8_BAR; }
    PG8_BAR;
#undef PG8_SA
#undef PG8_SB
#undef PG8_STAGE
#undef PG8_STAGE_A1
#undef PG8_LDA
#undef PG8_LDB
#undef PG8_MMA
#undef PG8_F8
#undef PG8_WAIT_V
#undef PG8_WAIT_L
#undef PG8_BAR
#undef PG8_SCHED
}
}

struct Args { const float* in[20]; float* out; unsigned char* ws; int ph_lo, ph_hi, sub, pad; };
enum { I_X = 0, I_C, I_WADA, I_BADA, I_G1, I_WIN, I_WCONV, I_BCONV, I_BGATES, I_GHEAD, I_WOUT, I_G2, I_WRG, I_BRG, I_WRE, I_BRE, I_WEG, I_WEU, I_WED, I_GFIN };

struct P0Item { const float* src; bf16_t* dst; int ldw, K, f8; };
__device__ __forceinline__ void p0_item_decode(const Args& a, int it, P0Item& I) {
    unsigned char* ws = a.ws;
    constexpr int I_W1 = 16 * 112, I_WO = 16 * 32, I_EXP = 768;
    int r = it;
    if (r < I_W1) { const int kb = r / 112, nb = r % 112, d0 = 32 * nb; I.f8 = 0; I.ldw = 3592; I.K = 1024; I.src = a.in[I_WIN] + (size_t)(64 * kb) * 3592 + (d0 < 2048 ? d0 : d0 + 8); I.dst = (bf16_t*)(ws + WS_W1T) + (size_t)d0 * 1024 + 64 * kb; return; }
    r -= I_W1;
    if (r < I_WO) { const int kb = r / 32, nb = r % 32; I.f8 = 0; I.ldw = 1024; I.K = 1024; I.src = a.in[I_WOUT] + (size_t)(64 * kb) * 1024 + 32 * nb; I.dst = (bf16_t*)(ws + WS_WOT) + (size_t)(32 * nb) * 1024 + 64 * kb; return; }
    r -= I_WO;
    const int e = r / I_EXP; r -= e * I_EXP;
    if (r < 512) { const int up = r >> 8, rr = r & 255, kb = rr / 16, nb = rr % 16, n0 = 32 * nb; I.ldw = 512; I.K = 1024;
        I.src = (up ? a.in[I_WEU] : a.in[I_WEG]) + (size_t)e * 1024 * 512 + (size_t)(64 * kb) * 512 + n0; I.f8 = 1; I.dst = (bf16_t*)(ws + WS_WGU + (size_t)e * 1024 * 1024 + (size_t)((n0 >> 7) * 256 + up * 128 + (n0 & 127)) * 1024 + 64 * kb); }
    else { const int rr = r - 512, kb = rr / 32, nb = rr % 32; I.ldw = 1024; I.K = 512;
        I.src = a.in[I_WED] + (size_t)e * 512 * 1024 + (size_t)(64 * kb) * 1024 + 32 * nb; I.f8 = 1; I.dst = (bf16_t*)(ws + WS_WD + (size_t)e * 1024 * 512 + (size_t)(32 * nb) * 512 + 64 * kb); }
}
__device__ __forceinline__ void p0_item_load(const P0Item& I, int lane, f32x4 (&ld)[8]) {
#pragma unroll
    for (int i = 0; i < 8; ++i) ld[i] = *(const f32x4*)(I.src + (size_t)(8 * i + (lane >> 3)) * I.ldw + 4 * (lane & 7));
}
__device__ __forceinline__ void p0_item_store(const P0Item& I, int lane, const f32x4 (&ld)[8], LAS float* scr) {
#pragma unroll
    for (int i = 0; i < 8; ++i) { LAS float* d = scr + (8 * i + (lane >> 3)) * 33 + 4 * (lane & 7); d[0] = ld[i].x; d[1] = ld[i].y; d[2] = ld[i].z; d[3] = ld[i].w; }
    LDS_WAIT(); asm volatile("" ::: "memory");
    if (I.f8) {
        const int n = lane & 31, hf = lane >> 5; const LAS float* s = scr + (32 * hf) * 33 + n; unsigned w[8];
#pragma unroll
        for (int q = 0; q < 8; ++q) w[q] = pk4_fp8(s[(4 * q) * 33] * 32.0f, s[(4 * q + 1) * 33] * 32.0f, s[(4 * q + 2) * 33] * 32.0f, s[(4 * q + 3) * 33] * 32.0f);
        unsigned char* d = (unsigned char*)I.dst + (size_t)n * I.K + 32 * hf;
        *(u32x4*)d = (u32x4){w[0], w[1], w[2], w[3]}; *(u32x4*)(d + 16) = (u32x4){w[4], w[5], w[6], w[7]};
    } else {
        const int c = lane >> 3;
#pragma unroll
        for (int j = 0; j < 4; ++j) { const int n = (lane & 7) + 8 * j; const LAS float* s = scr + (8 * c) * 33 + n;
            u32x4 o; o.x = pk2(s[0 * 33], s[1 * 33]); o.y = pk2(s[2 * 33], s[3 * 33]); o.z = pk2(s[4 * 33], s[5 * 33]); o.w = pk2(s[6 * 33], s[7 * 33]);
            *(u32x4*)(I.dst + (size_t)n * I.K + 8 * c) = o; }
    }
    LDS_WAIT(); asm volatile("" ::: "memory");
}
__device__ __forceinline__ void phase0(const Args& a, LAS unsigned char* lds, int gw, int NGW, int wave, int lane) {
    unsigned char* ws = a.ws;
    LAS float* scr = (LAS float*)(lds + wave * 16384);
    if (gw < 384) {
        const int g = lane >> 2, q = lane & 3, col0 = 16 * gw + 4 * q;
        const float* wp = a.in[I_WADA] + (size_t)(64 * g) * 6144 + col0;
        float acc[8][4];
#pragma unroll
        for (int b = 0; b < 8; ++b)
#pragma unroll
            for (int e = 0; e < 4; ++e) acc[b][e] = 0.f;
        for (int half = 0; half < 2; ++half) {
            for (int kk = q; kk < 32; kk += 4) {
#pragma unroll
                for (int b = 0; b < 8; ++b) { const float cv = a.in[I_C][b * 1024 + 64 * g + 32 * half + kk]; scr[(g * 8 + b) * 32 + kk] = cv / (1.0f + expf(-cv)); } }
            LDS_WAIT(); asm volatile("" ::: "memory");
            for (int it0 = 0; it0 < 32; it0 += 8) {
                f32x4 w8[8];
#pragma unroll
                for (int u = 0; u < 8; ++u) w8[u] = *(const f32x4*)(wp + (size_t)(32 * half + it0 + u) * 6144);
#pragma unroll
                for (int u = 0; u < 8; ++u)
#pragma unroll
                    for (int b = 0; b < 8; ++b) { const float sv = scr[(g * 8 + b) * 32 + it0 + u];
#pragma unroll
                        for (int e = 0; e < 4; ++e) acc[b][e] += sv * w8[u][e]; } }
            LDS_WAIT(); asm volatile("" ::: "memory");
        }
#pragma unroll
        for (int b = 0; b < 8; ++b)
#pragma unroll
            for (int e = 0; e < 4; ++e) { float v = acc[b][e]; v += __shfl_xor(v, 4); v += __shfl_xor(v, 8); v += __shfl_xor(v, 16); v += __shfl_xor(v, 32); acc[b][e] = v; }
        if (lane < 4) { float* mod = (float*)(ws + WS_MOD); const f32x4 ba = *(const f32x4*)(a.in[I_BADA] + col0);
#pragma unroll
            for (int b = 0; b < 8; ++b) *(f32x4*)(mod + b * 6144 + col0) = (f32x4){acc[b][0] + ba.x, acc[b][1] + ba.y, acc[b][2] + ba.z, acc[b][3] + ba.w}; }
        LDS_WAIT(); asm volatile("" ::: "memory");
    }
    constexpr int NITEMS = 16 * 112 + 16 * 32 + NEXP * 768;
    P0Item cur, nxt; f32x4 ld[8], ldn[8];
    int it = gw;
    if (it < NITEMS) { p0_item_decode(a, it, cur); p0_item_load(cur, lane, ld); }
    for (; it < NITEMS; it += NGW) {
        const bool more = it + NGW < NITEMS;
        if (more) { p0_item_decode(a, it + NGW, nxt); p0_item_load(nxt, lane, ldn); }
        p0_item_store(cur, lane, ld, scr);
        if (more) { cur = nxt;
#pragma unroll
            for (int i = 0; i < 8; ++i) ld[i] = ldn[i]; }
    }
}

__device__ __forceinline__ float tbfly8(const float (&v)[8], int lane) {
    const bool b5 = (lane & 32) != 0, b4 = (lane & 16) != 0, b3 = (lane & 8) != 0;
    float w[4], u[2], t;
#pragma unroll
    for (int i = 0; i < 4; ++i) { const float snd = b5 ? v[i] : v[4 + i], kp = b5 ? v[4 + i] : v[i]; w[i] = kp + __shfl_xor(snd, 32); }
#pragma unroll
    for (int i = 0; i < 2; ++i) { const float snd = b4 ? w[i] : w[2 + i], kp = b4 ? w[2 + i] : w[i]; u[i] = kp + __shfl_xor(snd, 16); }
    { const float snd = b3 ? u[0] : u[1], kp = b3 ? u[1] : u[0]; t = kp + __shfl_xor(snd, 8); }
    t += __shfl_xor(t, 4); t += __shfl_xor(t, 2); t += __shfl_xor(t, 1);
    return t;
}
__device__ __forceinline__ float rdlane(float v, int l) { return __int_as_float(__builtin_amdgcn_readlane(__float_as_int(v), l)); }

__device__ __forceinline__ void p1_rows2(const f32x4 (&x0)[4], const f32x4 (&x1)[4], const f32x4 (&A)[4], const f32x4 (&Bc)[4], const LAS float* wgT, const LAS float* cg, int row, int lane, bf16_t* hn, float* gates) {
    f32x4 t0[4], t1[4]; float ss0 = 0.f, ss1 = 0.f, ga0[8], ga1[8];
#pragma unroll
    for (int g = 0; g < 8; ++g) { ga0[g] = 0.f; ga1[g] = 0.f; }
#pragma unroll
    for (int j = 0; j < 4; ++j) {
        ss0 += (x0[j].x * x0[j].x + x0[j].y * x0[j].y) + (x0[j].z * x0[j].z + x0[j].w * x0[j].w); t0[j] = x0[j] * A[j];
        ss1 += (x1[j].x * x1[j].x + x1[j].y * x1[j].y) + (x1[j].z * x1[j].z + x1[j].w * x1[j].w); t1[j] = x1[j] * A[j];
#pragma unroll
        for (int g = 0; g < 8; ++g) { const f32x4 w = *(const LAS f32x4*)(wgT + g * 1024 + 256 * j + 4 * lane);
            ga0[g] += (t0[j].x * w.x + t0[j].y * w.y) + (t0[j].z * w.z + t0[j].w * w.w); ga1[g] += (t1[j].x * w.x + t1[j].y * w.y) + (t1[j].z * w.z + t1[j].w * w.w); }
        asm volatile("" ::: "memory"); }
    ss0 = wave_sum(ss0); ss1 = wave_sum(ss1);
    const float rstd0 = 1.0f / sqrtf(ss0 * (1.0f / DM) + EPS), rstd1 = 1.0f / sqrtf(ss1 * (1.0f / DM) + EPS);
    const float tot0 = tbfly8(ga0, lane), tot1 = tbfly8(ga1, lane);
#pragma unroll
    for (int j = 0; j < 4; ++j) { const f32x4 h0 = t0[j] * rstd0 + Bc[j], h1 = t1[j] * rstd1 + Bc[j];
        *(u32x2*)(hn + (size_t)row * DM + 256 * j + 4 * lane) = (u32x2){pk2(h0.x, h0.y), pk2(h0.z, h0.w)}; *(u32x2*)(hn + (size_t)(row + 1) * DM + 256 * j + 4 * lane) = (u32x2){pk2(h1.x, h1.y), pk2(h1.z, h1.w)}; }
    if ((lane & 7) == 0) { const float c = cg[lane >> 3]; gates[(size_t)row * 8 + (lane >> 3)] = tot0 * rstd0 + c; gates[(size_t)(row + 1) * 8 + (lane >> 3)] = tot1 * rstd1 + c; }
}
__device__ __forceinline__ void phase1(const Args& a, LAS unsigned char* lds, int blk, int tid, int wave, int lane) {
    unsigned char* ws = a.ws;
    LAS float* wgT = (LAS float*)lds;
    LAS float* cg = (LAS float*)(lds + 32768);
    for (int idx = tid; idx < 2048; idx += NTHREADS) { const int k = idx >> 1, q = idx & 1; const f32x4 v = *(const f32x4*)(a.in[I_WIN] + (size_t)k * 3592 + 2048 + 4 * q);
        LAS float* d = wgT + (4 * q) * 1024 + k; d[0] = v.x; d[1024] = v.y; d[2048] = v.z; d[3072] = v.w; }
    __syncthreads();
    const int b = blk >> 5; const float* mod = (const float*)(ws + WS_MOD) + b * 6144;
    f32x4 A[4], Bc[4];
#pragma unroll
    for (int j = 0; j < 4; ++j) { const int c0 = 256 * j + 4 * lane; const f32x4 g = *(const f32x4*)(a.in[I_G1] + c0), sc = *(const f32x4*)(mod + 1024 + c0); A[j] = g * (sc + 1.0f); Bc[j] = *(const f32x4*)(mod + c0); }
    { float s = 0.f;
#pragma unroll
      for (int j = 0; j < 4; ++j) { const f32x4 w = *(const LAS f32x4*)(wgT + wave * 1024 + 256 * j + 4 * lane); s += (Bc[j].x * w.x + Bc[j].y * w.y) + (Bc[j].z * w.z + Bc[j].w * w.w); }
      s = wave_sum(s); if (lane == 0) cg[wave] = s + a.in[I_BGATES][wave]; }
    __syncthreads();
    bf16_t* hn = (bf16_t*)(ws + WS_HN); float* gates = (float*)(ws + WS_GATES);
    const float* xb = a.in[I_X] + (size_t)(blk * 256 + wave * 32) * DM + 4 * lane;
    f32x4 nx[2][4];
#pragma unroll
    for (int r = 0; r < 2; ++r)
#pragma unroll
        for (int j = 0; j < 4; ++j) nx[r][j] = *(const f32x4*)(xb + (size_t)r * DM + 256 * j);
    for (int it = 0; it < 16; ++it) {
        f32x4 c0[4], c1[4];
#pragma unroll
        for (int j = 0; j < 4; ++j) { c0[j] = nx[0][j]; c1[j] = nx[1][j]; }
        if (it < 15) {
#pragma unroll
            for (int r = 0; r < 2; ++r)
#pragma unroll
                for (int j = 0; j < 4; ++j) nx[r][j] = *(const f32x4*)(xb + (size_t)(2 * it + 2 + r) * DM + 256 * j); }
        const int row = blk * 256 + wave * 32 + 2 * it;
        p1_rows2(c0, c1, A, Bc, wgT, cg, row, lane, hn, gates);
    }
}

__device__ __forceinline__ void p3_conv_tile(const bf16_t* src  , int tloc0, const float* wconv  , const float* bconv  ,
                                             float scale, bf16_t* dst, LAS unsigned char* scr, int lane) {
    const int rr = lane >> 3, ch = lane & 7;
#pragma unroll
    for (int li = 0; li < 9; ++li) { const int r = 8 * li + rr - 8; const bool ok = (tloc0 + r >= 0); u32x4 v = *(const u32x4*)(src + (ptrdiff_t)(ok ? r : 0) * 64 + 8 * ch); if (!ok) v = (u32x4){0u, 0u, 0u, 0u}; *(LAS u32x4*)(scr + (8 + r) * 144 + 16 * ch) = v; }
    float wc[4][8], bc[8];
#pragma unroll
    for (int j = 0; j < 4; ++j)
#pragma unroll
        for (int e = 0; e < 8; ++e) wc[j][e] = wconv[j * 1024 + 8 * ch + e];
#pragma unroll
    for (int e = 0; e < 8; ++e) bc[e] = bconv[8 * ch + e];
    LDS_WAIT(); asm volatile("" ::: "memory");
#pragma unroll
    for (int i = 0; i < 8; ++i) { const int r = 8 * i + rr; float o[8];
#pragma unroll
        for (int e = 0; e < 8; ++e) o[e] = bc[e];
#pragma unroll
        for (int j = 0; j < 4; ++j) { const u32x4 raw = *(const LAS u32x4*)(scr + (r + 5 + j) * 144 + 16 * ch); float f[8]; unpack8(raw, f);
#pragma unroll
            for (int e = 0; e < 8; ++e) o[e] += wc[j][e] * f[e]; }
#pragma unroll
        for (int e = 0; e < 8; ++e) o[e] = silu_f(o[e]) * scale;
        *(u32x4*)(dst + (size_t)r * 128 + 8 * ch) = (u32x4){pk2(o[0], o[1]), pk2(o[2], o[3]), pk2(o[4], o[5]), pk2(o[6], o[7])}; }
    LDS_WAIT(); asm volatile("" ::: "memory");
}
__device__ __forceinline__ float logsigmoidf_(float x) { return fminf(x, 0.f) - log1pf(expf(-fabsf(x))); }
__device__ __forceinline__ void phase3(const Args& a, LAS unsigned char* lds, int gw, int NGW, int wave, int lane) {
    unsigned char* ws = a.ws; const bf16_t* hm = (const bf16_t*)(ws + WS_QA);
    LAS unsigned char* scr = lds + wave * 16384;
    constexpr int NT3 = 8192;
    for (int it = gw; it < 2 * NT3 + 2048 + 1024; it += NGW) {
        if (it < 2 * NT3) {
            const int type = it / NT3, r = it % NT3, grp = r & 7, tch = (r >> 3) & 127, b = r >> 10, tloc0 = tch * 64;
            const size_t tok0 = (size_t)b * SEQ + tloc0;
            if (type == 0) { const int chan = 512 + grp * 64;
                p3_conv_tile(hm + 4 * HM_SEC + ((size_t)(b * 8 + grp) * SEQ + tloc0) * 64, tloc0, a.in[I_WCONV] + chan, a.in[I_BCONV] + chan, 1.0f, (bf16_t*)(ws + WS_KC) + ((size_t)(b * 4 + (grp >> 1)) * SEQ + tloc0) * 128 + (grp & 1) * 64, scr, lane); }
            else { const int chan = grp * 64;
                p3_conv_tile(hm + 3 * HM_SEC + ((size_t)(b * 8 + grp) * SEQ + tloc0) * 64, tloc0, a.in[I_WCONV] + chan, a.in[I_BCONV] + chan, 0.08838834764831845f, (bf16_t*)(ws + WS_QC) + ((size_t)(b * 4 + (grp >> 1)) * SEQ + tloc0) * 128 + (grp & 1) * 64, scr, lane); }
        } else if (it < 2 * NT3 + 2048) {
            const int r = it - 2 * NT3, h = r & 7, j = (r >> 3) & 31, b = r >> 8; const int rr = lane >> 3, ch = lane & 7;
            const bf16_t* src = (const bf16_t*)(ws + WS_QA) + HM_SEC + ((size_t)(b * 8 + h) * SEQ + j * 256) * 64 + 8 * ch;
            float s[8];
#pragma unroll
            for (int e = 0; e < 8; ++e) s[e] = 0.f;
#pragma unroll 8
            for (int li = 0; li < 32; ++li) { const u32x4 v = *(const u32x4*)(src + (size_t)(8 * li + rr) * 64); float f[8]; unpack8(v, f);
#pragma unroll
                for (int e = 0; e < 8; ++e) s[e] += f[e]; }
#pragma unroll
            for (int e = 0; e < 8; ++e) { float v = s[e]; v += __shfl_xor(v, 8); v += __shfl_xor(v, 16); v += __shfl_xor(v, 32); s[e] = v * (1.0f / 256.0f); }
            if (lane < 8) { float* km = (float*)(ws + WS_KMEAN) + ((size_t)(b * 8 + h) * 32 + j) * 64 + 8 * ch; *(f32x4*)km = (f32x4){s[0], s[1], s[2], s[3]}; *(f32x4*)(km + 4) = (f32x4){s[4], s[5], s[6], s[7]}; }
        } else {
            const int r = it - 2 * NT3 - 2048, sc = r & 31, bh = r >> 5, b = bh >> 2, h = bh & 3;
            const float* gates = (const float*)(ws + WS_GATES) + ((size_t)b * SEQ + sc * 256 + 4 * lane) * 8;
            float lf[4], ip[4];
#pragma unroll
            for (int e = 0; e < 4; ++e) { ip[e] = gates[e * 8 + h]; lf[e] = logsigmoidf_(gates[e * 8 + 4 + h]); }
            lf[1] += lf[0]; lf[2] += lf[1]; lf[3] += lf[2];
            float tot = lf[3], incl = tot;
#pragma unroll
            for (int o = 1; o < 64; o <<= 1) { const float t = __shfl_up(incl, o); if (lane >= o) incl += t; }
            const float excl = incl - tot;
            float av[4], amax = -INFINITY;
#pragma unroll
            for (int e = 0; e < 4; ++e) { lf[e] += excl; av[e] = ip[e] - lf[e]; amax = fmaxf(amax, av[e]); }
            amax = wave_max(amax);
            const size_t o = (size_t)bh * SEQ + sc * 256 + 4 * lane;
            *(f32x4*)((float*)(ws + WS_BCUM) + o) = (f32x4){lf[0], lf[1], lf[2], lf[3]};
            *(f32x4*)((float*)(ws + WS_AVAL) + o) = (f32x4){av[0], av[1], av[2], av[3]};
            const float blast = __shfl(lf[3], 63);
            if (lane == 0) { float* si = (float*)(ws + WS_SCINFO) + (size_t)(bh * 32 + sc) * 4; si[0] = amax; si[1] = blast; }
        }
    }
}

typedef short v4i16_t __attribute__((ext_vector_type(4)));
__device__ __forceinline__ u32x2 tr16(const LAS unsigned char* p) { return __builtin_bit_cast(u32x2, __builtin_amdgcn_ds_read_tr16_b64_v4i16((LAS v4i16_t*)p)); }

constexpr int SA_S = 288;
__device__ __forceinline__ void mlstm_stageA(const Args& a, LAS unsigned char* lds, int vcu, int G, int tid, int wave, int lane) {
    unsigned char* ws = a.ws; const int fr = lane & 15, fq = lane >> 4;
    LAS unsigned char* kt = lds;
    LAS unsigned char* vt = lds + 128 * SA_S;
    LAS float* wts = (LAS float*)(lds + 256 * SA_S);
    const bf16_t* vm = (const bf16_t*)(ws + WS_VM); const bf16_t* kc = (const bf16_t*)(ws + WS_KC);
    const int trow = 4 * fq + (fr >> 2), tcol = 4 * (fr & 3);
    for (int item = vcu; item < 1024; item += G) {
        const int bh = item >> 5, sc = item & 31, b = bh >> 2, h = bh & 3; const size_t tok0 = (size_t)b * SEQ + sc * 256;
        const float* si = (const float*)(ws + WS_SCINFO) + (size_t)item * 4;
        __syncthreads();
        if (tid < 256) wts[tid] = expf(((const float*)(ws + WS_AVAL))[(size_t)bh * SEQ + sc * 256 + tid] - si[0]);
        f32x4 acc[8];
#pragma unroll
        for (int n = 0; n < 8; ++n) acc[n] = (f32x4){0.f, 0.f, 0.f, 0.f};
        f32x4 accn = (f32x4){0.f, 0.f, 0.f, 0.f};
        for (int half = 0; half < 2; ++half) {
            if (half) __syncthreads();
#pragma unroll
            for (int i = 0; i < 4; ++i) { const int p = tid + NTHREADS * i, row = p >> 4, pc = p & 15; const size_t tk = ((size_t)bh * SEQ + sc * 256 + 128 * half + row) * 128 + 8 * pc;
                *(LAS u32x4*)(kt + row * SA_S + 16 * pc) = *(const u32x4*)(kc + tk);
                *(LAS u32x4*)(vt + row * SA_S + 16 * pc) = *(const u32x4*)(vm + tk); }
            __syncthreads();
#pragma unroll
            for (int ks = 0; ks < 4; ++ks) {
                const LAS unsigned char* ap = vt + (32 * ks + trow) * SA_S + (16 * wave + tcol) * 2;
                const u32x2 a0 = tr16(ap), a1 = tr16(ap + 16 * SA_S);
                const f32x4 w0 = *(const LAS f32x4*)(wts + 128 * half + 32 * ks + 4 * fq), w1 = *(const LAS f32x4*)(wts + 128 * half + 32 * ks + 16 + 4 * fq);
                const u32x4 ap4 = (u32x4){pk2(lo16(a0.x) * w0.x, hi16(a0.x) * w0.y), pk2(lo16(a0.y) * w0.z, hi16(a0.y) * w0.w), pk2(lo16(a1.x) * w1.x, hi16(a1.x) * w1.y), pk2(lo16(a1.y) * w1.z, hi16(a1.y) * w1.w)};
                const bf16x8 af = __builtin_bit_cast(bf16x8, ap4);
                const bf16x8 awf = (fr == 0) ? __builtin_bit_cast(bf16x8, (u32x4){pk2(w0.x, w0.y), pk2(w0.z, w0.w), pk2(w1.x, w1.y), pk2(w1.z, w1.w)}) : __builtin_bit_cast(bf16x8, (u32x4){0u, 0u, 0u, 0u});
#pragma unroll
                for (int n = 0; n < 8; ++n) { const LAS unsigned char* bp = kt + (32 * ks + trow) * SA_S + (16 * n + tcol) * 2;
                    const u32x2 b0 = tr16(bp), b1 = tr16(bp + 16 * SA_S); const bf16x8 bfr = __builtin_bit_cast(bf16x8, (u32x4){b0.x, b0.y, b1.x, b1.y});
                    acc[n] = __builtin_amdgcn_mfma_f32_16x16x32_bf16(af, bfr, acc[n], 0, 0, 0); }
                { const LAS unsigned char* bp = kt + (32 * ks + trow) * SA_S + (16 * wave + tcol) * 2; const u32x2 b0 = tr16(bp), b1 = tr16(bp + 16 * SA_S);
                  accn = __builtin_amdgcn_mfma_f32_16x16x32_bf16(awf, __builtin_bit_cast(bf16x8, (u32x4){b0.x, b0.y, b1.x, b1.y}), accn, 0, 0, 0); }
            }
        }
        if (fq == 0) ((float*)(ws + WS_NLOC))[(size_t)item * 128 + 16 * wave + fr] = accn[0];
        float* cl = (float*)(ws + WS_CLOC) + (size_t)item * 16384;
#pragma unroll
        for (int n = 0; n < 8; ++n)
#pragma unroll
            for (int j = 0; j < 4; ++j) cl[(16 * wave + 4 * fq + j) * 128 + 16 * n + fr] = acc[n][j];
    }
}

__device__ __forceinline__ void moba_gate(const Args& a, LAS unsigned char* lds, int blk, int tid, int wave, int lane) {
    unsigned char* ws = a.ws; const int b = blk >> 5, pp = blk & 31, half = pp >> 4;
    LAS float* km = (LAS float*)lds;
    __syncthreads();
    { const float* src = (const float*)(ws + WS_KMEAN) + (size_t)b * 8 * 32 * 64;
      for (int i = tid; i < 4096; i += NTHREADS) *(LAS f32x4*)(km + 4 * i) = *(const f32x4*)(src + 4 * i); }
    __syncthreads();
    const int h = wave;
    for (int r = 0; r < 4; ++r) {
        const int own = (r < 2) ? pp : 31 - pp;
        unsigned* sel = (unsigned*)(ws + WS_SEL) + (size_t)(b * 8 + h) * SEQ + own * 256;
        const int tl = 128 * half + lane + 64 * (r & 1); const bf16_t* qp = (const bf16_t*)(ws + WS_QA) + ((size_t)(b * 8 + h) * SEQ + own * 256 + tl) * 64;
        float q[64];
#pragma unroll
        for (int c = 0; c < 8; ++c) { const u32x4 v = *(const u32x4*)(qp + 8 * c); unpack8(v, q + 8 * c); }
        float b0 = -INFINITY, b1 = -INFINITY, b2 = -INFINITY; unsigned i0 = 0xFFu, i1 = 0xFFu, i2 = 0xFFu;
        for (int j = 0; j < own; ++j) { const LAS float* kp = km + (h * 32 + j) * 64; float d0 = 0.f, d1 = 0.f;
#pragma unroll
            for (int c = 0; c < 16; ++c) { const f32x4 kv = *(const LAS f32x4*)(kp + 4 * c); d0 += q[4 * c] * kv.x + q[4 * c + 2] * kv.z; d1 += q[4 * c + 1] * kv.y + q[4 * c + 3] * kv.w; }
            const float g = d0 + d1;
            if (g > b0) { b2 = b1; i2 = i1; b1 = b0; i1 = i0; b0 = g; i0 = (unsigned)j; }
            else if (g > b1) { b2 = b1; i2 = i1; b1 = g; i1 = (unsigned)j; }
            else if (g > b2) { b2 = g; i2 = (unsigned)j; } }
        sel[tl] = i0 | (i1 << 8) | (i2 << 16) | 0xFF000000u;
    }
}

__device__ __forceinline__ int crow(int r, int hi) { return (r & 3) + 8 * (r >> 2) + 4 * hi; }
constexpr int MB_KS = 144, MB_VS = 192;
constexpr int MB_K = 0, MB_V = 256 * MB_KS, MB_Q = MB_V + 256 * MB_VS, MB_WT = MB_Q + 16384, MB_ST = MB_WT + 64, MB_STS = 144, MB_STW = 32 * MB_STS + 256;
static_assert(MB_ST + 8 * MB_STW <= MISC_OFF, "MoBA LDS map");
constexpr float SM_SCALE_LOG2 = 0.125f * 1.4426950408889634f;
__device__ __forceinline__ void moba_stage_kv(const bf16_t* qkv, int b, int h, int j, LAS unsigned char* lds, int tid) {
    const bf16_t* kp = qkv + HM_SEC + ((size_t)(b * 8 + h) * SEQ + j * 256) * 64;
#pragma unroll
    for (int i = 0; i < 4; ++i) { const int p = tid + NTHREADS * i, row = p >> 3, ch = p & 7;
        { const u32x4 kv = *(const u32x4*)(kp + (size_t)row * 64 + 8 * ch); float f[8]; unpack8(kv, f);
          *(LAS u32x4*)(lds + MB_K + row * MB_KS + 16 * ch) = (u32x4){pk2(f[0] * SM_SCALE_LOG2, f[1] * SM_SCALE_LOG2), pk2(f[2] * SM_SCALE_LOG2, f[3] * SM_SCALE_LOG2), pk2(f[4] * SM_SCALE_LOG2, f[5] * SM_SCALE_LOG2), pk2(f[6] * SM_SCALE_LOG2, f[7] * SM_SCALE_LOG2)}; }
        *(LAS u32x4*)(lds + MB_V + row * MB_VS + 16 * ch) = *(const u32x4*)(kp + HM_SEC + (size_t)row * 64 + 8 * ch); }
}
__device__ __forceinline__ bf16x8 moba_vfrag(const LAS unsigned char* vbase  , int kt, int s2, int d0) {
    const LAS unsigned char* p = vbase + (32 * kt + 16 * s2) * MB_VS + 64 * d0;
    const u32x2 v0 = tr16(p), v1 = tr16(p + 8 * MB_VS);
    return __builtin_bit_cast(bf16x8, (u32x4){v0.x, v0.y, v1.x, v1.y});
}
template <bool DIAG>
__device__ __forceinline__ void moba_wave_attn(LAS unsigned char* lds, const bf16x8 (&qf)[4], int nkt, int qpos, int lane, f32x16 (&o)[2], float& m_out, float& l_out) {
    const int r32 = lane & 31, hi = lane >> 5;
    const LAS unsigned char* vbase = lds + MB_V + (4 * hi + ((lane & 15) >> 2)) * MB_VS + (16 * ((lane >> 4) & 1) + 4 * (lane & 3)) * 2;
    const LAS unsigned char* kbase = lds + MB_K + r32 * MB_KS + 16 * hi;
    float m = -INFINITY, l = 0.f;
    o[0] = f32x16{}; o[1] = f32x16{};
#pragma unroll 1
    for (int kp = 0; 2 * kp < nkt; ++kp) {
        const bool two = (2 * kp + 1 < nkt);
        bf16x8 kf[2][4];
#pragma unroll
        for (int k2 = 0; k2 < 2; ++k2)
#pragma unroll
            for (int d0 = 0; d0 < 4; ++d0) kf[k2][d0] = *(const LAS bf16x8*)(kbase + (32 * (2 * kp + k2)) * MB_KS + 32 * d0);
        LDS_WAIT(); __builtin_amdgcn_sched_barrier(0);
        f32x16 p[2];
#pragma unroll
        for (int k2 = 0; k2 < 2; ++k2) { f32x16 s = {};
#pragma unroll
            for (int d0 = 0; d0 < 4; ++d0) s = __builtin_amdgcn_mfma_f32_32x32x16_bf16(kf[k2][d0], qf[d0], s, 0, 0, 0);
            p[k2] = s; }
        if (!two) {
#pragma unroll
            for (int r = 0; r < 16; ++r) p[1][r] = -INFINITY; }
        if (DIAG) { const int kl = nkt - 1 - 2 * kp;
            if (kl == 0) {
#pragma unroll
                for (int r = 0; r < 16; ++r) if (32 * (2 * kp) + crow(r, hi) > qpos) p[0][r] = -INFINITY; }
            else if (kl == 1) {
#pragma unroll
                for (int r = 0; r < 16; ++r) if (32 * (2 * kp + 1) + crow(r, hi) > qpos) p[1][r] = -INFINITY; } }
        bf16x8 vf[2][2][2];
#pragma unroll
        for (int k2 = 0; k2 < 2; ++k2)
#pragma unroll
            for (int s2 = 0; s2 < 2; ++s2)
#pragma unroll
                for (int d0 = 0; d0 < 2; ++d0) vf[k2][s2][d0] = moba_vfrag(vbase, 2 * kp + k2, s2, d0);
        float tm = p[0][0];
#pragma unroll
        for (int k2 = 0; k2 < 2; ++k2)
#pragma unroll
            for (int r = 0; r < 16; ++r) tm = fmaxf(tm, p[k2][r]);
        tm = fmaxf(tm, __shfl_xor(tm, 32));
        const float mn = fmaxf(m, tm);
        const float alpha = __builtin_amdgcn_exp2f(m - mn);
        float ls = 0.f;
#pragma unroll
        for (int k2 = 0; k2 < 2; ++k2)
#pragma unroll
            for (int r = 0; r < 16; ++r) { const float e = __builtin_amdgcn_exp2f(p[k2][r] - mn); p[k2][r] = e; ls += e; }
        l = l * alpha + ls; m = mn;
#pragma unroll
        for (int r = 0; r < 16; ++r) { o[0][r] *= alpha; o[1][r] *= alpha; }
        bf16x8 pb[2][2];
#pragma unroll
        for (int k2 = 0; k2 < 2; ++k2)
#pragma unroll
            for (int s2 = 0; s2 < 2; ++s2) pb[k2][s2] = __builtin_bit_cast(bf16x8, (u32x4){pk2(p[k2][8 * s2], p[k2][8 * s2 + 1]), pk2(p[k2][8 * s2 + 2], p[k2][8 * s2 + 3]), pk2(p[k2][8 * s2 + 4], p[k2][8 * s2 + 5]), pk2(p[k2][8 * s2 + 6], p[k2][8 * s2 + 7])});
        LDS_WAIT(); __builtin_amdgcn_sched_barrier(0);
#pragma unroll
        for (int k2 = 0; k2 < 2; ++k2)
#pragma unroll
            for (int s2 = 0; s2 < 2; ++s2)
#pragma unroll
                for (int d0 = 0; d0 < 2; ++d0) o[d0] = __builtin_amdgcn_mfma_f32_32x32x16_bf16(vf[k2][s2][d0], pb[k2][s2], o[d0], 0, 0, 0);
    }
    m_out = m; l_out = l + __shfl_xor(l, 32);
}
template <int VAR = 0>
__device__ __forceinline__ void moba_wave_attn_full(LAS unsigned char* lds, const bf16x8 (&qf)[4], int lane, f32x16 (&o)[2], float& m_out, float& l_out) {
    const int r32 = lane & 31, hi = lane >> 5;
    const LAS unsigned char* vbase = lds + MB_V + (4 * hi + ((lane & 15) >> 2)) * MB_VS + (16 * ((lane >> 4) & 1) + 4 * (lane & 3)) * 2;
    const LAS unsigned char* kbase = lds + MB_K + r32 * MB_KS + 16 * hi;
    float l = 0.f;
    o[0] = f32x16{}; o[1] = f32x16{};
    float nm = 0.f;
#pragma unroll
    for (int hg = 0; hg < 2; ++hg) {
        f32x16 p[4];
#pragma unroll
        for (int kp = 0; kp < 2; ++kp) {
            bf16x8 kf[2][4];
#pragma unroll
            for (int k2 = 0; k2 < 2; ++k2)
#pragma unroll
                for (int d0 = 0; d0 < 4; ++d0) kf[k2][d0] = *(const LAS bf16x8*)(kbase + (32 * (4 * hg + 2 * kp + k2)) * MB_KS + 32 * d0);
            LDS_WAIT(); __builtin_amdgcn_sched_barrier(0);
            if (hg == 0 && kp == 0) {
                f32x16 s = {};
#pragma unroll
                for (int d0 = 0; d0 < 4; ++d0) s = __builtin_amdgcn_mfma_f32_32x32x16_bf16(kf[0][d0], qf[d0], s, 0, 0, 0);
                float mx = s[0];
#pragma unroll
                for (int r = 1; r < 16; ++r) mx = fmaxf(mx, s[r]);
                mx = fmaxf(mx, __shfl_xor(mx, 32));
#pragma unroll
                for (int r = 0; r < 16; ++r) s[r] -= mx;
                nm = -mx; m_out = mx; p[0] = s; }
#pragma unroll
            for (int k2 = ((hg == 0 && kp == 0) ? 1 : 0); k2 < 2; ++k2) { f32x16 s;
#pragma unroll
                for (int r = 0; r < 16; ++r) s[r] = nm;
#pragma unroll
                for (int d0 = 0; d0 < 4; ++d0) s = __builtin_amdgcn_mfma_f32_32x32x16_bf16(kf[k2][d0], qf[d0], s, 0, 0, 0);
                p[2 * kp + k2] = s; }
        }
#pragma unroll
        for (int k4 = 0; k4 < 4; ++k4) {
            bf16x8 vf[2][2];
#pragma unroll
            for (int s2 = 0; s2 < 2; ++s2)
#pragma unroll
                for (int d0 = 0; d0 < 2; ++d0) vf[s2][d0] = moba_vfrag(vbase, 4 * hg + k4, s2, d0);
            bf16x8 pb[2];
#pragma unroll
            for (int r = 0; r < 16; ++r) { const float e = (VAR == 2) ? p[k4][r] * 0.001f : __builtin_amdgcn_exp2f(p[k4][r]); p[k4][r] = e; l += e; }
#pragma unroll
            for (int s2 = 0; s2 < 2; ++s2) pb[s2] = __builtin_bit_cast(bf16x8, (u32x4){pk2(p[k4][8 * s2], p[k4][8 * s2 + 1]), pk2(p[k4][8 * s2 + 2], p[k4][8 * s2 + 3]), pk2(p[k4][8 * s2 + 4], p[k4][8 * s2 + 5]), pk2(p[k4][8 * s2 + 6], p[k4][8 * s2 + 7])});
            LDS_WAIT(); __builtin_amdgcn_sched_barrier(0);
#pragma unroll
            for (int s2 = 0; s2 < 2; ++s2)
#pragma unroll
                for (int d0 = 0; d0 < 2; ++d0) o[d0] = __builtin_amdgcn_mfma_f32_32x32x16_bf16(vf[s2][d0], pb[s2], o[d0], 0, 0, 0);
        }
    }
    l_out = l + __shfl_xor(l, 32);
}

template <int VAR = 0>
__device__ __forceinline__ void moba_partial(const Args& a, float* dout, LAS unsigned char* lds, int vcu, int wave) {
    unsigned char* ws = a.ws; const bf16_t* proj = (const bf16_t*)(ws + WS_QA);
    bf16_t* slots = (bf16_t*)((unsigned char*)dout + DO_SLOTS); float* mlb = (float*)((unsigned char*)dout + DO_ML);
    LAS unsigned short* queue = (LAS unsigned short*)(lds + MB_Q);
    LAS unsigned* wtot = (LAS unsigned*)(lds + MB_WT);
    const int bh = vcu >> 2, s4 = vcu & 3, b = bh >> 3, h = bh & 7;
    const unsigned* sel = (const unsigned*)(ws + WS_SEL) + (size_t)bh * SEQ;
    for (int ii = 0; ii < 8; ++ii) {
        const int j = (ii & 1) ? (8 * (ii >> 1) + 7 - s4) : (8 * (ii >> 1) + s4);
        if (j >= 31) continue;
        const int lane = fresh_lane(), tid = wave * 64 + lane, r32 = lane & 31, hi = lane >> 5;
        __syncthreads();
        moba_stage_kv(proj, b, h, j, lds, tid);
        const int tstart = 256 * (j + 1);
        unsigned w[16]; int cnt = 0;
#pragma unroll
        for (int c4 = 0; c4 < 4; ++c4) { const int t = tstart + 16 * tid + 4 * c4; const u32x4 x = *(const u32x4*)(sel + (t < SEQ ? t : SEQ - 4));
            w[4 * c4] = (t < SEQ) ? x.x : 0xFFFFFFFFu; w[4 * c4 + 1] = (t < SEQ) ? x.y : 0xFFFFFFFFu; w[4 * c4 + 2] = (t < SEQ) ? x.z : 0xFFFFFFFFu; w[4 * c4 + 3] = (t < SEQ) ? x.w : 0xFFFFFFFFu; }
#pragma unroll
        for (int ck = 0; ck < 16; ++ck) { const unsigned x = w[ck]; const int slot = ((x & 0xFFu) == (unsigned)j) ? 0 : (((x >> 8) & 0xFFu) == (unsigned)j) ? 1 : (((x >> 16) & 0xFFu) == (unsigned)j) ? 2 : 3; w[ck] = (unsigned)slot; cnt += (slot < 3) ? 1 : 0; }
        int incl = cnt;
#pragma unroll
        for (int o = 1; o < 64; o <<= 1) { const int t = __shfl_up(incl, o); if (lane >= o) incl += t; }
        if (lane == 63) wtot[wave] = (unsigned)incl;
        __syncthreads();
        unsigned base = 0, total = 0;
#pragma unroll
        for (int w8 = 0; w8 < 8; ++w8) { const unsigned c = wtot[w8]; if (w8 < wave) base += c; total += c; }
        unsigned off = base + (unsigned)(incl - cnt);
#pragma unroll
        for (int ck = 0; ck < 16; ++ck) { if (w[ck] < 3u) { queue[off] = (unsigned short)((unsigned)(tstart + 16 * tid + ck) | (w[ck] << 13)); ++off; } }
        __syncthreads();
        unsigned ent_n = (unsigned)tstart; bool val_n = false; bf16x8 qf_n[4];
        { const unsigned avail = total; const bool act = (unsigned)(32 * wave) < avail; val_n = (unsigned)(32 * wave + r32) < avail;
          if (act) { ent_n = (unsigned)queue[val_n ? 32 * wave + r32 : 0]; if (!val_n) ent_n = (unsigned)tstart; const bf16_t* qp = proj + ((size_t)bh * SEQ + (ent_n & 0x1FFFu)) * 64 + 8 * hi;
#pragma unroll
              for (int d0 = 0; d0 < 4; ++d0) qf_n[d0] = *(const bf16x8*)(qp + 16 * d0); } }
        for (unsigned qhead = 0; qhead < ((VAR == 4) ? 0u : total); qhead += 256u) {
            const unsigned avail = total - qhead;
            const bool act = (unsigned)(32 * wave) < avail;
            const unsigned ent = ent_n; const bool valid = val_n; bf16x8 qf[4];
#pragma unroll
            for (int d0 = 0; d0 < 4; ++d0) qf[d0] = qf_n[d0];
            if (avail > 256u) { const unsigned av2 = avail - 256u;
                if ((unsigned)(32 * wave) < av2) { val_n = (unsigned)(32 * wave + r32) < av2; ent_n = (unsigned)queue[val_n ? qhead + 256u + 32 * wave + r32 : 0u]; if (!val_n) ent_n = (unsigned)tstart;
                    const bf16_t* qp = proj + ((size_t)bh * SEQ + (ent_n & 0x1FFFu)) * 64 + 8 * hi;
#pragma unroll
                    for (int d0 = 0; d0 < 4; ++d0) qf_n[d0] = *(const bf16x8*)(qp + 16 * d0); } }
            float m = 0.f, l = 0.f;
            LAS unsigned char* stg = lds + MB_ST + wave * MB_STW;
            if (act) {
                f32x16 o[2];
                if (VAR == 1) { o[0] = f32x16{}; o[1] = f32x16{}; m = 0.f; l = 1.f; asm volatile("" :: "v"(qf[0]), "v"(qf[1]), "v"(qf[2]), "v"(qf[3])); } else
                moba_wave_attn_full<VAR>(lds, qf, lane, o, m, l);
#pragma unroll
                for (int d0 = 0; d0 < 2; ++d0)
#pragma unroll
                    for (int g = 0; g < 4; ++g) *(LAS u32x2*)(stg + r32 * MB_STS + (32 * d0 + 8 * g + 4 * hi) * 2) = (u32x2){pk2(o[d0][4 * g], o[d0][4 * g + 1]), pk2(o[d0][4 * g + 2], o[d0][4 * g + 3])};
            }
#pragma unroll
            for (int d0 = 0; d0 < 4; ++d0) asm volatile("" : "+v"(qf_n[d0]));
            asm volatile("" : "+v"(ent_n));
            if (act) {
                const int t = (int)(ent & 0x1FFFu), slot = (int)(ent >> 13);
                if (VAR != 3 && valid && hi == 0) *(f32x2*)(mlb + (((size_t)bh * SEQ + t) * 3 + slot) * 2) = (f32x2){m, l};
                LDS_WAIT(); asm volatile("" ::: "memory");
#pragma unroll
                for (int i = 0; i < 4; ++i) { const int row = 8 * i + (lane >> 3), ch = lane & 7;
                    if (VAR != 3 && (unsigned)(32 * wave + row) < avail) { const unsigned e2 = queue[qhead + 32 * wave + row]; const int t2 = (int)(e2 & 0x1FFFu), s2 = (int)(e2 >> 13);
                        *(u32x4*)(slots + (((size_t)bh * SEQ + t2) * 3 + s2) * 64 + 8 * ch) = *(const LAS u32x4*)(stg + row * MB_STS + 16 * ch); } }
                LDS_WAIT(); asm volatile("" ::: "memory");
            }
        }
    }
}

__device__ __forceinline__ void moba_own(const Args& a, const float* dout, LAS unsigned char* lds, int vcu, int wave) {
    unsigned char* ws = a.ws; const bf16_t* proj = (const bf16_t*)(ws + WS_QA);
    const bf16_t* slots = (const bf16_t*)((const unsigned char*)dout + DO_SLOTS); const float* mlb = (const float*)((const unsigned char*)dout + DO_ML);
    bf16_t* hcat = (bf16_t*)(ws + WS_HCAT);
    const int b = vcu >> 5, blk = vcu & 31;
    for (int ii = 0; ii < 8; ++ii) {
        const int h = ii, bh = b * 8 + h;
        const unsigned* sel = (const unsigned*)(ws + WS_SEL) + (size_t)bh * SEQ;
        const int lane = fresh_lane(), tid = wave * 64 + lane, r32 = lane & 31, hi = lane >> 5;
        __syncthreads();
        moba_stage_kv(proj, b, h, blk, lds, tid);
        const int tq = blk * 256 + 32 * wave + r32;
        const bf16_t* qp = proj + ((size_t)bh * SEQ + tq) * 64 + 8 * hi;
        bf16x8 qf[4];
#pragma unroll
        for (int d0 = 0; d0 < 4; ++d0) qf[d0] = *(const bf16x8*)(qp + 16 * d0);
        const int ch = lane & 7;
        u32x4 sv[4][3]; f32x2 mls[4][3]; unsigned swv[4];
#pragma unroll
        for (int i = 0; i < 4; ++i) { const int t = blk * 256 + 32 * wave + 8 * i + (lane >> 3); const size_t tg = (size_t)b * SEQ + t; const unsigned sw = sel[t];
#pragma unroll
            for (int s = 0; s < 3; ++s) { const size_t sidx = ((size_t)bh * SEQ + t) * 3 + s;
                mls[i][s] = *(const f32x2*)(mlb + sidx * 2);
                sv[i][s] = *(const u32x4*)(slots + sidx * 64 + 8 * ch); }
            swv[i] = sw; }
        __syncthreads();
        f32x16 o[2]; float m, l;
        moba_wave_attn<true>(lds, qf, wave + 1, 32 * wave + r32, lane, o, m, l);
        LAS unsigned char* stg = lds + MB_ST + wave * MB_STW; LAS float* mst = (LAS float*)(stg + 32 * MB_STS);
#pragma unroll
        for (int d0 = 0; d0 < 2; ++d0)
#pragma unroll
            for (int g = 0; g < 4; ++g) *(LAS u32x2*)(stg + r32 * MB_STS + (32 * d0 + 8 * g + 4 * hi) * 2) = (u32x2){pk2(o[d0][4 * g], o[d0][4 * g + 1]), pk2(o[d0][4 * g + 2], o[d0][4 * g + 3])};
        if (hi == 0) { mst[r32] = m; mst[32 + r32] = l; }
        LDS_WAIT(); asm volatile("" ::: "memory");
#pragma unroll
        for (int i = 0; i < 4; ++i) { const int row = 8 * i + (lane >> 3); const size_t tg = (size_t)b * SEQ + blk * 256 + 32 * wave + row;
            const float mo = mst[row], lo = mst[32 + row];
#pragma unroll
            for (int s = 0; s < 3; ++s) { if (((swv[i] >> (8 * s)) & 0xFFu) == 0xFFu) { mls[i][s] = (f32x2){-INFINITY, 0.f}; sv[i][s] = (u32x4){0u, 0u, 0u, 0u}; } }
            const float M = fmaxf(fmaxf(mo, mls[i][0].x), fmaxf(mls[i][1].x, mls[i][2].x));
            const float w0 = __builtin_amdgcn_exp2f(mo - M); float den = lo * w0;
            float acc[8]; { const u32x4 ov = *(const LAS u32x4*)(stg + row * MB_STS + 16 * ch); unpack8(ov, acc); }
#pragma unroll
            for (int e = 0; e < 8; ++e) acc[e] *= w0;
#pragma unroll
            for (int s = 0; s < 3; ++s) { const float ww = __builtin_amdgcn_exp2f(mls[i][s].x - M); den += mls[i][s].y * ww; float f[8]; unpack8(sv[i][s], f);
#pragma unroll
                for (int e = 0; e < 8; ++e) acc[e] += f[e] * ww; }
            const float inv = 1.0f / den;
            *(u32x4*)(hcat + tg * DM + 512 + h * 64 + 8 * ch) = (u32x4){pk2(acc[0] * inv, acc[1] * inv), pk2(acc[2] * inv, acc[3] * inv), pk2(acc[4] * inv, acc[5] * inv), pk2(acc[6] * inv, acc[7] * inv)}; }
    }
}

__device__ __forceinline__ void mlstm_scan(const Args& a, int blk, int tid) {
    unsigned char* ws = a.ws; const float* scw = (const float*)(ws + WS_SCW);
    const int gid = blk * NTHREADS + tid;
    for (int k = 0; k < 4; ++k) {
        const int elem = gid + 131072 * k, bh = elem >> 14, idx = elem & 16383;
        const float* cl = (const float*)(ws + WS_CLOC) + (size_t)bh * 32 * 16384 + idx; bf16_t* cs = (bf16_t*)(ws + WS_CST) + (size_t)bh * 32 * 16384 + idx;
        float v[32];
#pragma unroll
        for (int sc = 0; sc < 32; ++sc) v[sc] = cl[(size_t)sc * 16384];
        float C = 0.f;
#pragma unroll
        for (int sc = 0; sc < 32; ++sc) { const f32x2 w = *(const f32x2*)(scw + (bh * 32 + sc) * 2);
            cs[(size_t)sc * 16384] = (bf16_t)f2bf(C);
            C = w.x * C + w.y * v[sc]; }
    }
    if (gid < 32 * 128) {
        const int bh = gid >> 7, d = gid & 127; const float* nl = (const float*)(ws + WS_NLOC) + (size_t)bh * 32 * 128 + d; float* ns = (float*)(ws + WS_NST) + (size_t)bh * 32 * 128 + d;
        float v[32];
#pragma unroll
        for (int sc = 0; sc < 32; ++sc) v[sc] = nl[sc * 128];
        float n = 0.f;
#pragma unroll
        for (int sc = 0; sc < 32; ++sc) { const f32x2 w = *(const f32x2*)(scw + (bh * 32 + sc) * 2);
            ns[sc * 128] = n;
            n = w.x * n + w.y * v[sc]; }
    }
}

constexpr int MC_KS = 272, MC_VS = 288;
constexpr int MC_K = 0, MC_V = 256 * MC_KS, MC_A = MC_V + 256 * MC_VS, MC_B = MC_A + 1024, MC_MU = MC_B + 1024, MC_N = MC_MU + 1024, MC_G = MC_N + 512, MC_END = MC_G + 512;
static_assert(MC_END <= MISC_OFF, "stage C LDS map");
__device__ __forceinline__ void mlstm_stageC(const Args& a, LAS unsigned char* lds, int vcu, int G, int wave) {
    unsigned char* ws = a.ws; const bf16_t* vm = (const bf16_t*)(ws + WS_VM); bf16_t* hcat = (bf16_t*)(ws + WS_HCAT);
    const bf16_t* kc = (const bf16_t*)(ws + WS_KC); const bf16_t* qc = (const bf16_t*)(ws + WS_QC);
    LAS float* av = (LAS float*)(lds + MC_A); LAS float* bc = (LAS float*)(lds + MC_B); LAS float* mu = (LAS float*)(lds + MC_MU); LAS float* nst = (LAS float*)(lds + MC_N); LAS float* ghs = (LAS float*)(lds + MC_G);
    for (int kk = 0; kk < 4; ++kk) {
        const int item = ((vcu >> 5) * 4 + kk) * 32 + (vcu & 31);
        const int lane = fresh_lane(), tid = wave * 64 + lane, fr = lane & 15, fq = lane >> 4;
        const LAS unsigned char* vbase = lds + MC_V + (4 * fq + (fr >> 2)) * MC_VS + (4 * (fr & 3)) * 2;
        const int bh = item >> 5, sc = item & 31, b = bh >> 2, h = bh & 3, t0 = sc * 256; const size_t tok0 = (size_t)b * SEQ + t0, hrow0 = (size_t)bh * SEQ + t0;
        const float* si = (const float*)(ws + WS_SCINFO) + (size_t)item * 4; const float mstart = si[2];
        const int tl = tid;
        bf16x8 qf[2][4];
#pragma unroll
        for (int qq = 0; qq < 2; ++qq) { const int tq = 16 * (qq ? (15 - wave) : wave) + fr; const bf16_t* qp = qc + (hrow0 + tq) * 128 + 8 * fq;
#pragma unroll
            for (int ks = 0; ks < 4; ++ks) qf[qq][ks] = *(const bf16x8*)(qp + 32 * ks);
}
        __syncthreads();
        { const bf16_t* cst = (const bf16_t*)(ws + WS_CST) + (size_t)item * 16384;
#pragma unroll
          for (int i = 0; i < 4; ++i) { const int p = tl + NTHREADS * i, row = p >> 4, pc = p & 15; *(LAS u32x4*)(lds + MC_K + row * MC_KS + 16 * pc) = *(const u32x4*)(cst + row * 128 + 8 * pc); } }
#pragma unroll
        for (int i = 0; i < 8; ++i) { const int p = tl + NTHREADS * i, row = p >> 4, pc = p & 15;
            *(LAS u32x4*)(lds + MC_V + row * MC_VS + 16 * pc) = *(const u32x4*)(vm + (hrow0 + row) * 128 + 8 * pc); }
        if (tl >= 64 && tl < 320) { const int t = tl - 64; av[t] = ((const float*)(ws + WS_AVAL))[(size_t)bh * SEQ + t0 + t]; bc[t] = ((const float*)(ws + WS_BCUM))[(size_t)bh * SEQ + t0 + t]; }
        if (tl >= 320 && tl < 448) { nst[tl - 320] = ((const float*)(ws + WS_NST))[(size_t)item * 128 + tl - 320]; ghs[tl - 320] = a.in[I_GHEAD][h * 128 + tl - 320]; }
        if (wave == 0) {
            const f32x4 a4 = *(const f32x4*)((const float*)(ws + WS_AVAL) + (size_t)bh * SEQ + t0 + 4 * lane);
            float x[4]; float run = -INFINITY;
#pragma unroll
            for (int e = 0; e < 4; ++e) { run = fmaxf(run, a4[e]); x[e] = run; }
            float incl = run;
#pragma unroll
            for (int o = 1; o < 64; o <<= 1) { const float t = __shfl_up(incl, o); if (lane >= o) incl = fmaxf(incl, t); }
            float excl = __shfl_up(incl, 1); if (lane == 0) excl = -INFINITY;
#pragma unroll
            for (int e = 0; e < 4; ++e) mu[4 * lane + e] = fmaxf(mstart, fmaxf(excl, x[e]));
        }
        __syncthreads();
        f32x4 acc[2][8]; float qn[2], muq[2], wint[2];
#pragma unroll
        for (int qq = 0; qq < 2; ++qq) { const int tq = 16 * (qq ? (15 - wave) : wave) + fr; muq[qq] = mu[tq]; wint[qq] = fexp(mstart - muq[qq]);
            float s = 0.f;
#pragma unroll
            for (int ks = 0; ks < 4; ++ks) { float f[8]; unpack8(__builtin_bit_cast(u32x4, qf[qq][ks]), f);
#pragma unroll
                for (int e = 0; e < 8; ++e) s += f[e] * nst[32 * ks + 8 * fq + e]; }
            s += __shfl_xor(s, 16); s += __shfl_xor(s, 32); qn[qq] = s; }
#pragma unroll
        for (int m = 0; m < 8; ++m) { f32x4 c0 = (f32x4){0.f, 0.f, 0.f, 0.f}, c1 = c0;
#pragma unroll
            for (int ks = 0; ks < 4; ++ks) { const bf16x8 cf = *(const LAS bf16x8*)(lds + MC_K + (16 * m + fr) * MC_KS + (32 * ks + 8 * fq) * 2);
                c0 = __builtin_amdgcn_mfma_f32_16x16x32_bf16(cf, qf[0][ks], c0, 0, 0, 0); c1 = __builtin_amdgcn_mfma_f32_16x16x32_bf16(cf, qf[1][ks], c1, 0, 0, 0); }
            acc[0][m] = c0 * wint[0]; acc[1][m] = c1 * wint[1]; asm volatile("" : "+v"(acc[0][m]), "+v"(acc[1][m]) :: "memory"); }
        __syncthreads();
#pragma unroll
        for (int i = 0; i < 8; ++i) { const int p = tl + NTHREADS * i, row = p >> 4, pc = p & 15;
            *(LAS u32x4*)(lds + MC_K + row * MC_KS + 16 * pc) = *(const u32x4*)(kc + (hrow0 + row) * 128 + 8 * pc); }
        __syncthreads();
#pragma unroll
        for (int qq = 0; qq < 2; ++qq) {
            const int qt = qq ? (15 - wave) : wave, tq = 16 * qt + fr;
            const float mu_q = muq[qq];
            float den = 0.f;
            for (int g = 0; g <= (qt >> 1); ++g) {
                f32x4 s[2];
#pragma unroll
                for (int j = 0; j < 2; ++j) { f32x4 c = (f32x4){0.f, 0.f, 0.f, 0.f};
#pragma unroll
                    for (int ks = 0; ks < 4; ++ks) { const bf16x8 kf = *(const LAS bf16x8*)(lds + MC_K + (32 * g + 16 * j + fr) * MC_KS + (32 * ks + 8 * fq) * 2); c = __builtin_amdgcn_mfma_f32_16x16x32_bf16(kf, qf[qq][ks], c, 0, 0, 0); }
                    s[j] = c; }
                float pv[8];
#pragma unroll
                for (int j = 0; j < 2; ++j) { const f32x4 a4 = *(const LAS f32x4*)(av + 32 * g + 16 * j + 4 * fq);
#pragma unroll
                    for (int r = 0; r < 4; ++r) { const int key = 32 * g + 16 * j + 4 * fq + r; const float w = (key <= tq) ? fexp(a4[r] - mu_q) : 0.f; const float p = s[j][r] * w; pv[4 * j + r] = p; den += p; } }
                const bf16x8 pb = __builtin_bit_cast(bf16x8, (u32x4){pk2(pv[0], pv[1]), pk2(pv[2], pv[3]), pk2(pv[4], pv[5]), pk2(pv[6], pv[7])});
#pragma unroll
                for (int m = 0; m < 8; ++m) { const LAS unsigned char* vp = vbase + (32 * g) * MC_VS + 32 * m;
                    const u32x2 v0 = tr16(vp), v1 = tr16(vp + 16 * MC_VS);
                    acc[qq][m] = __builtin_amdgcn_mfma_f32_16x16x32_bf16(__builtin_bit_cast(bf16x8, (u32x4){v0.x, v0.y, v1.x, v1.y}), pb, acc[qq][m], 0, 0, 0); if ((m & 3) == 3) asm volatile("" ::: "memory"); }
            }
            den += __shfl_xor(den, 16); den += __shfl_xor(den, 32);
            den += wint[qq] * qn[qq];
            const float flo = fexp(-(bc[tq] + mu_q));
            const float inv = 1.0f / fmaxf(fabsf(den), flo);
            float ss = 0.f;
#pragma unroll
            for (int m = 0; m < 8; ++m) { acc[qq][m] = acc[qq][m] * inv; ss += (acc[qq][m].x * acc[qq][m].x + acc[qq][m].y * acc[qq][m].y) + (acc[qq][m].z * acc[qq][m].z + acc[qq][m].w * acc[qq][m].w); }
            ss += __shfl_xor(ss, 16); ss += __shfl_xor(ss, 32);
            const float rstd = 1.0f / sqrtf(ss * (1.0f / 128.0f) + EPS);
#pragma unroll
            for (int m = 0; m < 8; ++m) acc[qq][m] = acc[qq][m] * rstd;
        }
        __syncthreads();
        { LAS unsigned char* stg = lds + MC_K + wave * (2 * 16 * MC_KS);
#pragma unroll
          for (int qq = 0; qq < 2; ++qq)
#pragma unroll
              for (int m = 0; m < 8; ++m) *(LAS u32x2*)(stg + (qq * 16 + fr) * MC_KS + (16 * m + 4 * fq) * 2) = (u32x2){pk2(acc[qq][m].x, acc[qq][m].y), pk2(acc[qq][m].z, acc[qq][m].w)};
          LDS_WAIT(); asm volatile("" ::: "memory");
          const int ch = lane & 15;
          const f32x4 g0 = *(const LAS f32x4*)(ghs + 8 * ch), g1 = *(const LAS f32x4*)(ghs + 8 * ch + 4);
#pragma unroll
          for (int qq = 0; qq < 2; ++qq) { const int qt = qq ? (15 - wave) : wave;
              u32x4 omv[4];
#pragma unroll
              for (int i = 0; i < 4; ++i) omv[i] = *(const u32x4*)(vm + HM_SEC + (hrow0 + 16 * qt + 4 * i + (lane >> 4)) * 128 + 8 * ch);
#pragma unroll
              for (int i = 0; i < 4; ++i) { const int row = 4 * i + (lane >> 4); float hv[8], ov[8];
                  unpack8(*(const LAS u32x4*)(stg + (qq * 16 + row) * MC_KS + 16 * ch), hv); unpack8(omv[i], ov);
                  const float gg[8] = {g0.x, g0.y, g0.z, g0.w, g1.x, g1.y, g1.z, g1.w}; float r8[8];
#pragma unroll
                  for (int e = 0; e < 8; ++e) r8[e] = hv[e] * gg[e] * __builtin_amdgcn_rcpf(1.0f + fexp(-ov[e]));
                  *(u32x4*)(hcat + (tok0 + 16 * qt + row) * DM + h * 128 + 8 * ch) = (u32x4){pk2(r8[0], r8[1]), pk2(r8[2], r8[3]), pk2(r8[4], r8[5]), pk2(r8[6], r8[7])}; } }
          LDS_WAIT(); asm volatile("" ::: "memory"); }
    }
}

constexpr int P8_WS = 2064;
constexpr int P8_WH = 0, P8_WL = 36 * P8_WS, P8_AV = 2 * 36 * P8_WS, P8_HIST = P8_AV + 4096, P8_CG = P8_HIST + 128;
static_assert(P8_CG + 144 <= MISC_OFF, "phase 8 LDS map");
__device__ __forceinline__ void phase8(const Args& a, LAS unsigned char* lds, int blk, int tid, int wave, int lane) {
    unsigned char* ws = a.ws;
    LAS float* av = (LAS float*)(lds + P8_AV); LAS int* hist = (LAS int*)(lds + P8_HIST); LAS float* cg = (LAS float*)(lds + P8_CG);
    LAS float* red = av;
    const int b = blk >> 5; const float* mod = (const float*)(ws + WS_MOD) + b * 6144;
    __syncthreads();
    { float pe[4] = {0.f, 0.f, 0.f, 0.f}; const int q = tid & 7, g = q >> 1, hf = q & 1;
      for (int i = 0; i < 16; ++i) { const int k = (tid >> 3) + 64 * i; const f32x4 v = *(const f32x4*)(a.in[I_WRE] + (size_t)k * 32 + 4 * q); const float bk = mod[3072 + k];
#pragma unroll
          for (int r = 0; r < 4; ++r) { const float w = v[r]; const unsigned hi = pk2(w, 0.f) & 0xFFFFu; const unsigned lo = pk2(w - bf2f(hi), 0.f) & 0xFFFFu; const int srow = (hf ? 20 : 4) + 4 * g + r;
              *(LAS unsigned short*)(lds + P8_WH + srow * P8_WS + 2 * k) = (unsigned short)hi; *(LAS unsigned short*)(lds + P8_WL + srow * P8_WS + 2 * k) = (unsigned short)lo; pe[r] += bk * w; } }
#pragma unroll
      for (int r = 0; r < 4; ++r) { float v = pe[r]; v += __shfl_xor(v, 8); v += __shfl_xor(v, 16); v += __shfl_xor(v, 32); pe[r] = v; }
      float pg[4] = {0.f, 0.f, 0.f, 0.f};
      for (int i = 0; i < 2; ++i) { const int k = tid + 512 * i; const f32x4 v = *(const f32x4*)(a.in[I_WRG] + (size_t)k * 4); const float bk = mod[3072 + k];
#pragma unroll
          for (int r = 0; r < 4; ++r) { const float w = v[r]; const unsigned hi = pk2(w, 0.f) & 0xFFFFu; const unsigned lo = pk2(w - bf2f(hi), 0.f) & 0xFFFFu;
              *(LAS unsigned short*)(lds + P8_WH + r * P8_WS + 2 * k) = (unsigned short)hi; *(LAS unsigned short*)(lds + P8_WL + r * P8_WS + 2 * k) = (unsigned short)lo; pg[r] += bk * w; } }
#pragma unroll
      for (int r = 0; r < 4; ++r) pg[r] = wave_sum(pg[r]);
      if (lane < 8) {
#pragma unroll
          for (int r = 0; r < 4; ++r) red[wave * 36 + 4 + 4 * lane + r] = pe[r]; }
      if (lane == 0) {
#pragma unroll
          for (int r = 0; r < 4; ++r) red[wave * 36 + r] = pg[r]; }
      if (tid < 32) hist[tid] = 0; }
    __syncthreads();
    if (tid < 36) { float s = 0.f;
#pragma unroll
        for (int w = 0; w < 8; ++w) s += red[w * 36 + tid];
        cg[tid] = s + ((tid < 4) ? a.in[I_BRG][tid] : a.in[I_BRE][tid - 4]); }
    __syncthreads();
    for (int k = tid; k < 1024; k += NTHREADS) av[k] = a.in[I_G2][k] * (1.0f + mod[4096 + k]);
    __syncthreads();
    const int fr = lane & 15, fq = lane >> 4; const int R0 = blk * 256 + wave * 32;
    const bf16_t* x1b = (const bf16_t*)(ws + WS_X1B);
    const bf16_t* xr = x1b + (size_t)(R0 + fr) * DM + 8 * fq;
    const LAS unsigned char* wp0 = lds + (fr & 3) * P8_WS + 16 * fq; const LAS unsigned char* wp1 = lds + (4 + fr) * P8_WS + 16 * fq; const LAS unsigned char* wp2 = lds + (20 + fr) * P8_WS + 16 * fq;
    f32x4 acc[2][3]; float ssq[2] = {0.f, 0.f};
#pragma unroll
    for (int rt = 0; rt < 2; ++rt)
#pragma unroll
        for (int j = 0; j < 3; ++j) acc[rt][j] = (f32x4){0.f, 0.f, 0.f, 0.f};
    u32x4 xc[2][4], xn[2][4];
#pragma unroll
    for (int rt = 0; rt < 2; ++rt)
#pragma unroll
        for (int u = 0; u < 4; ++u) xc[rt][u] = *(const u32x4*)(xr + (size_t)(16 * rt) * DM + 32 * u);
    for (int ks0 = 0; ks0 < 32; ks0 += 4) {
        if (ks0 + 4 < 32) {
#pragma unroll
            for (int rt = 0; rt < 2; ++rt)
#pragma unroll
                for (int u = 0; u < 4; ++u) xn[rt][u] = *(const u32x4*)(xr + (size_t)(16 * rt) * DM + 32 * (ks0 + 4 + u)); }
#pragma unroll
        for (int u = 0; u < 4; ++u) { const int ks = ks0 + u;
            const f32x4 a0 = *(const LAS f32x4*)(av + 32 * ks + 8 * fq), a1 = *(const LAS f32x4*)(av + 32 * ks + 8 * fq + 4);
            bf16x8 wh[3], wl[3];
            wh[0] = *(const LAS bf16x8*)(wp0 + P8_WH + 64 * ks); wh[1] = *(const LAS bf16x8*)(wp1 + P8_WH + 64 * ks); wh[2] = *(const LAS bf16x8*)(wp2 + P8_WH + 64 * ks);
            wl[0] = *(const LAS bf16x8*)(wp0 + P8_WL + 64 * ks); wl[1] = *(const LAS bf16x8*)(wp1 + P8_WL + 64 * ks); wl[2] = *(const LAS bf16x8*)(wp2 + P8_WL + 64 * ks);
#pragma unroll
            for (int rt = 0; rt < 2; ++rt) { float x[8]; unpack8(xc[rt][u], x);
                ssq[rt] += ((x[0] * x[0] + x[1] * x[1]) + (x[2] * x[2] + x[3] * x[3])) + ((x[4] * x[4] + x[5] * x[5]) + (x[6] * x[6] + x[7] * x[7]));
                float t[8] = {x[0] * a0.x, x[1] * a0.y, x[2] * a0.z, x[3] * a0.w, x[4] * a1.x, x[5] * a1.y, x[6] * a1.z, x[7] * a1.w};
                const u32x4 th = (u32x4){pk2(t[0], t[1]), pk2(t[2], t[3]), pk2(t[4], t[5]), pk2(t[6], t[7])}; float hf8[8]; unpack8(th, hf8);
                const u32x4 tl = (u32x4){pk2(t[0] - hf8[0], t[1] - hf8[1]), pk2(t[2] - hf8[2], t[3] - hf8[3]), pk2(t[4] - hf8[4], t[5] - hf8[5]), pk2(t[6] - hf8[6], t[7] - hf8[7])};
                const bf16x8 bh = __builtin_bit_cast(bf16x8, th), bl = __builtin_bit_cast(bf16x8, tl);
#pragma unroll
                for (int j = 0; j < 3; ++j) { f32x4 c = acc[rt][j];
                    c = __builtin_amdgcn_mfma_f32_16x16x32_bf16(wh[j], bh, c, 0, 0, 0); c = __builtin_amdgcn_mfma_f32_16x16x32_bf16(wh[j], bl, c, 0, 0, 0); c = __builtin_amdgcn_mfma_f32_16x16x32_bf16(wl[j], bh, c, 0, 0, 0);
                    acc[rt][j] = c; } } }
#pragma unroll
        for (int rt = 0; rt < 2; ++rt)
#pragma unroll
            for (int u = 0; u < 4; ++u) xc[rt][u] = xn[rt][u];
    }
    int* eid = (int*)(ws + WS_EID); float* ew = (float*)(ws + WS_EW);
    float rstd[2];
#pragma unroll
    for (int rt = 0; rt < 2; ++rt) {
        float ss = ssq[rt]; ss += __shfl_xor(ss, 16); ss += __shfl_xor(ss, 32);
        rstd[rt] = 1.0f / sqrtf(ss * (1.0f / DM) + EPS);
        const f32x4 c4 = *(const LAS f32x4*)cg; float gl[4] = {acc[rt][0][0] * rstd[rt] + c4.x, acc[rt][0][1] * rstd[rt] + c4.y, acc[rt][0][2] * rstd[rt] + c4.z, acc[rt][0][3] * rstd[rt] + c4.w};
        int gi = 0; float gm = gl[0];
#pragma unroll
        for (int g = 1; g < 4; ++g) { const bool gt = gl[g] > gm; gm = gt ? gl[g] : gm; gi = gt ? g : gi; }
        float gs = 0.f;
#pragma unroll
        for (int g = 0; g < 4; ++g) gs += fexp(gl[g] - gm);
        const float gw_ = 1.0f / gs;
        const f32x4 ca = *(const LAS f32x4*)(cg + 4 + fq * 8), cb = *(const LAS f32x4*)(cg + 8 + fq * 8);
        float sv[8] = {acc[rt][1][0] * rstd[rt] + ca.x, acc[rt][1][1] * rstd[rt] + ca.y, acc[rt][1][2] * rstd[rt] + ca.z, acc[rt][1][3] * rstd[rt] + ca.w,
                       acc[rt][2][0] * rstd[rt] + cb.x, acc[rt][2][1] * rstd[rt] + cb.y, acc[rt][2][2] * rstd[rt] + cb.z, acc[rt][2][3] * rstd[rt] + cb.w};
        float t0 = sv[0]; int e0 = 0;
#pragma unroll
        for (int e = 1; e < 8; ++e) { const bool gt = sv[e] > t0; t0 = gt ? sv[e] : t0; e0 = gt ? e : e0; }
        float tt1 = -INFINITY; int e1 = 0;
#pragma unroll
        for (int e = 0; e < 8; ++e) { const bool c = (e != e0) && (sv[e] > tt1); tt1 = c ? sv[e] : tt1; e1 = c ? e : e1; }
        const float p1 = fexp(tt1 - t0), inv = 1.0f / (1.0f + p1);
        if (fq == gi) { const int row = R0 + 16 * rt + fr; *(u32x2*)(eid + row * 2) = (u32x2){(unsigned)(gi * 8 + e0), (unsigned)(gi * 8 + e1)}; *(f32x2*)(ew + row * 2) = (f32x2){inv * gw_, p1 * inv * gw_};
            __hip_atomic_fetch_add(&hist[gi * 8 + e0], 1, __ATOMIC_RELAXED, __HIP_MEMORY_SCOPE_WORKGROUP); __hip_atomic_fetch_add(&hist[gi * 8 + e1], 1, __ATOMIC_RELAXED, __HIP_MEMORY_SCOPE_WORKGROUP); }
    }
    f32x4 A[4], Bc[4];
#pragma unroll
    for (int j = 0; j < 4; ++j) { const int c0 = 256 * j + 4 * lane; const f32x4 g = *(const f32x4*)(a.in[I_G2] + c0), sc = *(const f32x4*)(mod + 4096 + c0); A[j] = g * (sc + 1.0f); Bc[j] = *(const f32x4*)(mod + 3072 + c0); }
    unsigned char* hn = ws + WS_HN2; const bf16_t* xb = x1b + (size_t)R0 * DM + 4 * lane;
    u32x2 bx[3][4];
#define P8_LOAD(S, R) do { _Pragma("unroll") for (int j = 0; j < 4; ++j) bx[S][j] = *(const u32x2*)(xb + (size_t)(R) * DM + 256 * j); } while (0)
#define P8_ROW(S, R) do { const int r_ = (R); const float rs = __shfl((r_ < 16) ? rstd[0] : rstd[1], r_ & 15); \
        _Pragma("unroll") for (int j = 0; j < 4; ++j) { const f32x4 v = (f32x4){lo16(bx[S][j].x), hi16(bx[S][j].x), lo16(bx[S][j].y), hi16(bx[S][j].y)}; const f32x4 h = v * A[j] * rs + Bc[j]; \
            *(unsigned*)(hn + (size_t)(R0 + r_) * DM + 256 * j + 4 * lane) = pk4_fp8(h.x, h.y, h.z, h.w); } } while (0)
    P8_LOAD(0, 0); P8_LOAD(1, 1);
    for (int i = 0; i < 30; i += 3) {
        P8_LOAD(2, i + 2); P8_ROW(0, i);
        P8_LOAD(0, i + 3); P8_ROW(1, i + 1);
        P8_LOAD(1, i + 4); P8_ROW(2, i + 2);
    }
    P8_ROW(0, 30); P8_ROW(1, 31);
#undef P8_LOAD
#undef P8_ROW
    __syncthreads();
    if (tid < 32) ((int*)(ws + WS_BCNT))[blk * 32 + tid] = hist[tid];
}

__device__ __forceinline__ void phase9(const Args& a, LAS unsigned char* lds, int blk, int tid, int wave, int lane) {
    unsigned char* ws = a.ws;
    LAS int* tot = (LAS int*)lds; LAS int* pre = tot + 32; LAS int* pstart = pre + 32;
    LAS int* wcnt = pstart + 40;
    LAS int* posl = wcnt + 256;
    const int* bcnt = (const int*)(ws + WS_BCNT);
    __syncthreads();
    if (tid < 32) { int t = 0, p = 0; for (int c = 0; c < 256; ++c) { const int v = bcnt[c * 32 + tid]; if (c < blk) p += v; t += v; } tot[tid] = t; pre[tid] = p; }
    __syncthreads();
    if (tid == 0) { int run = 0; for (int e = 0; e < 32; ++e) { pstart[e] = run; run += ((tot[e] + 255) >> 8) << 8; } pstart[32] = run; if (blk == 0) *(int*)(ws + WS_NTILES) = run >> 8; }
    __syncthreads();
    if (blk == 0) { const int ntl = pstart[32] >> 8; int* te = (int*)(ws + WS_TILEE);
        for (int rt = tid; rt < ntl; rt += NTHREADS) { int e = 0; for (int k = 1; k < 32; ++k) if (rt * 256 >= pstart[k]) e = k; te[rt] = e; } }
    const int tl = tid >> 1, slot = tid & 1, tok = blk * 256 + tl;
    const int e = ((const int*)(ws + WS_EID))[tok * 2 + slot];
    int myrank = 0;
    for (int k = 0; k < 32; ++k) { const unsigned long long bal = __ballot(e == k); if (e == k) myrank = __popcll(bal & ((1ull << lane) - 1ull)); if (lane == 0) wcnt[wave * 32 + k] = __popcll(bal); }
    __syncthreads();
    int rank = myrank; for (int w = 0; w < wave; ++w) rank += wcnt[w * 32 + e];
    const int pos = pstart[e] + pre[e] + rank;
    ((int*)(ws + WS_POSOF))[tok * 2 + slot] = pos; ((int*)(ws + WS_ROWTOK))[pos] = tok;
    if (blk < 32) { for (int p = pstart[blk] + tot[blk] + tid; p < pstart[blk + 1]; p += NTHREADS) ((int*)(ws + WS_ROWTOK))[p] = 0; }
}

__device__ __forceinline__ f32x4 fp8x4_to_f32(unsigned w) {
    const f32x2 lo = __builtin_amdgcn_cvt_pk_f32_fp8((int)w, false), hi = __builtin_amdgcn_cvt_pk_f32_fp8((int)w, true);
    return (f32x4){lo.x, lo.y, hi.x, hi.y};
}
__device__ __forceinline__ void phase12(const Args& a, float* out, bool with_ffn, int blk, int wave, int lane) {
    unsigned char* ws = a.ws; const int b = blk >> 5; const float* mod = (const float*)(ws + WS_MOD) + b * 6144 + 5120;
    f32x4 G2[4], GF[4];
#pragma unroll
    for (int j = 0; j < 4; ++j) { const int c0 = 256 * j + 4 * lane; G2[j] = *(const f32x4*)(mod + c0); GF[j] = *(const f32x4*)(a.in[I_GFIN] + c0); }
    const unsigned char* ys = ws + WS_YS; const int* posof = (const int*)(ws + WS_POSOF); const float* ew = (const float*)(ws + WS_EW);
    const int row0 = blk * 256 + wave * 32;
    const u32x2 pp = *(const u32x2*)(posof + (size_t)(row0 + (lane & 31)) * 2); const f32x2 ww = *(const f32x2*)(ew + (size_t)(row0 + (lane & 31)) * 2);
    const bf16_t* xb = (const bf16_t*)(ws + WS_X1B) + (size_t)row0 * DM + 4 * lane;
    float* ob = out + (size_t)row0 * DM + 4 * lane;
    u32x2 bx[3][4]; unsigned by0[3][4], by1[3][4];
#define P12_LOAD(S, R) do { const int r_ = (R); const int p0_ = __shfl((int)pp.x, r_), p1_ = __shfl((int)pp.y, r_); \
        _Pragma("unroll") for (int j = 0; j < 4; ++j) { bx[S][j] = *(const u32x2*)(xb + (size_t)r_ * DM + 256 * j); by0[S][j] = *(const unsigned*)(ys + (size_t)p0_ * DM + 256 * j + 4 * lane); by1[S][j] = *(const unsigned*)(ys + (size_t)p1_ * DM + 256 * j + 4 * lane); } } while (0)
#define P12_ROW(S, R) do { const int r_ = (R); const float w0 = __shfl(ww.x, r_), w1 = __shfl(ww.y, r_); f32x4 v[4]; float ss = 0.f; \
        _Pragma("unroll") for (int j = 0; j < 4; ++j) { v[j] = (f32x4){lo16(bx[S][j].x), hi16(bx[S][j].x), lo16(bx[S][j].y), hi16(bx[S][j].y)}; \
            if (with_ffn) v[j] += G2[j] * (fp8x4_to_f32(by0[S][j]) * w0 + fp8x4_to_f32(by1[S][j]) * w1); \
            ss += (v[j].x * v[j].x + v[j].y * v[j].y) + (v[j].z * v[j].z + v[j].w * v[j].w); } \
        ss = wave_sum(ss); const float rstd = 1.0f / sqrtf(ss * (1.0f / DM) + EPS); \
        _Pragma("unroll") for (int j = 0; j < 4; ++j) *(f32x4*)(ob + (size_t)r_ * DM + 256 * j) = v[j] * rstd * GF[j]; } while (0)
    P12_LOAD(0, 0); P12_LOAD(1, 1);
    for (int i = 0; i < 30; i += 3) {
        P12_LOAD(2, i + 2); P12_ROW(0, i);
        P12_LOAD(0, i + 3); P12_ROW(1, i + 1);
        P12_LOAD(1, i + 4); P12_ROW(2, i + 2);
    }
    P12_ROW(0, 30); P12_ROW(1, 31);
#undef P12_LOAD
#undef P12_ROW
}

constexpr int NPHASES = 13;
__global__ void __launch_bounds__(NTHREADS, 2) fwd_kernel(Args args) {
    extern __shared__ __attribute__((aligned(16))) unsigned char lds_raw[];
    LAS unsigned char* lds = (LAS unsigned char*)lds_raw;
    volatile LAS unsigned* MISC = (volatile LAS unsigned*)(lds + MISC_OFF);
    const int wave = __builtin_amdgcn_readfirstlane((int)threadIdx.x >> 6);
#define lane fresh_lane()
#define tid (wave * 64 + fresh_lane())
    const int G = gridDim.x, blk = blockIdx.x;
    const int vcu = (G % 8 == 0) ? (blk % 8) * (G / 8) + blk / 8 : blk;
    const int gw = vcu * NWAVES + wave, NGW = G * NWAVES;
    unsigned char* ws = args.ws;
    if (threadIdx.x < 32) MISC[threadIdx.x] = 0u;
    __syncthreads();
    const int lo = args.ph_lo, hi = args.ph_hi;
    const int sub_lo = args.sub;
#define SUBM ((lo == PH_CUR) ? sub_lo : 3)
    const bool one_launch = (hi - lo) > 1;
    XcdBarrier bar; bar.bar = (unsigned*)(ws + WS_CTL) + CW_BAR; bar.x = 0; bar.st = nullptr;
    if (one_launch) bar = xcd_barrier_post((unsigned*)(ws + WS_CTL) + CW_BAR, MISC + 8);
#ifndef PHASE_MASK
#define PHASE_MASK 0x1FFF
#endif
#define IN(k) ((((PHASE_MASK) >> (k)) & 1) && lo <= (k) && (k) < hi)
#define SEAM(k) do { if (IN(k) && IN((k) + 1)) xcd_barrier(bar, wave == 0 && fresh_lane() == 0); } while (0)

    if (IN(0)) { phase0(args, lds, gw, NGW, wave, lane); } SEAM(0);
    if (IN(1)) { for (int r = vcu; r < 256; r += G) phase1(args, lds, r, tid, wave, lane); } SEAM(1);
    if (IN(2)) {
        pg8::DenseOrder S; S.init(ws + WS_HN, ws + WS_W1T, NTOK, NPROJ, 1024, G, blk);
        pg8::EpiProj E{(bf16_t*)(ws + WS_QA), (bf16_t*)(ws + WS_VM)};
        pg8::gemm_phase<1024, pg8::EpiProj, pg8::DenseOrder, true>(lds, S, E, wave);
    } SEAM(2);
    if (IN(3)) { phase3(args, lds, gw, NGW, wave, lane); } SEAM(3);
#define PH_CUR 4
    if (IN(4)) {
        const int t4 = tid;
        if (blk == G - 1 && t4 < 32) {
            const float* si = (const float*)(ws + WS_SCINFO) + (size_t)t4 * 32 * 4; float* so = (float*)(ws + WS_SCINFO) + (size_t)t4 * 32 * 4; float* sw = (float*)(ws + WS_SCW) + (size_t)t4 * 32 * 2;
            f32x2 ab[32];
#pragma unroll
            for (int sc = 0; sc < 32; ++sc) ab[sc] = *(const f32x2*)(si + sc * 4);
            float m = 0.f;
#pragma unroll
            for (int sc = 0; sc < 32; ++sc) { const float amax = ab[sc].x, blast = ab[sc].y; so[sc * 4 + 2] = m; const float mu = fmaxf(m, amax); *(f32x2*)(sw + sc * 2) = (f32x2){fexp(m - mu), fexp(amax - mu)}; m = blast + mu; }
        }
        if (SUBM & 1) mlstm_stageA(args, lds, vcu, G, tid, wave, lane);
        if (SUBM & 2) for (int r = vcu; r < 256; r += G) moba_gate(args, lds, r, tid, wave, lane); } SEAM(4);
#undef PH_CUR
#define PH_CUR 5
    if (IN(5)) { if (SUBM & 1) for (int r = blk; r < 256; r += G) mlstm_scan(args, r, tid); if (SUBM & 2) {
#ifdef PROBE_VAR
            if (args.pad == PROBE_VAR) { for (int r = vcu; r < 256; r += G) moba_partial<PROBE_VAR>(args, args.out, lds, r, wave); } else
#endif
            for (int r = vcu; r < 256; r += G) moba_partial<0>(args, args.out, lds, r, wave); } } SEAM(5);
#undef PH_CUR
#define PH_CUR 6
    if (IN(6)) {
        if (SUBM & 1) mlstm_stageC(args, lds, vcu, G, wave);
        if (SUBM & 2) for (int r = vcu; r < 256; r += G) moba_own(args, args.out, lds, r, wave);
    }
#define LOCAL_SEAM(k) do { if (IN(k) && IN((k) + 1)) { asm volatile("s_waitcnt vmcnt(0)" ::: "memory"); __syncthreads(); __builtin_amdgcn_fence(__ATOMIC_ACQUIRE, "agent"); asm volatile("s_waitcnt vmcnt(0)" ::: "memory"); __syncthreads(); } } while (0)
    LOCAL_SEAM(6);
    if (IN(7)) {
        __syncthreads();
        pg8::RowMajorOrder S; S.init(ws + WS_HCAT, ws + WS_WOT, NTOK, DM, 1024, G, vcu);
        pg8::EpiRes E{args.in[I_X], (bf16_t*)(ws + WS_X1B), (const float*)(ws + WS_MOD) + 2048};
        pg8::gemm_phase<1024, pg8::EpiRes, pg8::RowMajorOrder, true>(lds, S, E, wave);
    } LOCAL_SEAM(7);
    if (IN(8)) { for (int r = vcu; r < 256; r += G) phase8(args, lds, r, tid, wave, lane); } SEAM(8);
    if (IN(9)) { for (int r = vcu; r < 256; r += G) phase9(args, lds, r, tid, wave, lane); } SEAM(9);
    if (IN(10)) {
        __syncthreads();
        const int ntl = *(const int*)(ws + WS_NTILES);
        pg8::MoeOrder S{(const int*)(ws + WS_TILEE), ntl * 4, G, vcu, (const char*)(ws + WS_HN2), (const char*)(ws + WS_WGU), (size_t)0, (size_t)1024 * 1024, (size_t)256 * 1024};
        pg8::EpiSwigluF8 E{ws + WS_HB};
        pg8::gemm_phase_fp8<1024, pg8::EpiSwigluF8, pg8::MoeOrder, true, true, 122>(lds, S, E, wave, (const int*)(ws + WS_ROWTOK));
    } SEAM(10);
    if (IN(11)) {
        const int ntl = *(const int*)(ws + WS_NTILES);
        pg8::MoeOrder S{(const int*)(ws + WS_TILEE), ntl * 4, G, vcu, (const char*)(ws + WS_HB), (const char*)(ws + WS_WD), (size_t)256 * 512, (size_t)1024 * 512, (size_t)256 * 512};
        pg8::EpiF8 E{ws + WS_YS, DM};
        pg8::gemm_phase_fp8<512, pg8::EpiF8, pg8::MoeOrder, true, false, 122>(lds, S, E, wave, nullptr);
    } SEAM(11);
    if (IN(12)) { for (int r = vcu; r < 256; r += G) phase12(args, args.out, true, r, wave, lane); }
#undef IN
#undef SEAM
#undef LOCAL_SEAM
#undef lane
#undef tid
}

#ifndef MK_PER_PHASE
#define MK_PER_PHASE 0
#endif
extern "C" void kernel_launch(void* const* d_in, const int* in_sizes, int n_in, void* d_out, int out_size, void* d_ws, size_t ws_size, hipStream_t stream) {
    static int grid = 0;
    if (grid == 0) {
        if (n_in != 20 || out_size != NTOK * DM || ws_size < WS_END) { fprintf(stderr, "kernel_launch: unexpected shapes (n_in %d out %d ws %zu)\n", n_in, out_size, ws_size); grid = -1; return; }
        int dev = 0, cus = 0, per_cu = 0;
        if (hipGetDevice(&dev) != hipSuccess || hipDeviceGetAttribute(&cus, hipDeviceAttributeMultiprocessorCount, dev) != hipSuccess) { grid = -1; return; }
        if (hipFuncSetAttribute((const void*)fwd_kernel, hipFuncAttributeMaxDynamicSharedMemorySize, LDS_BYTES) != hipSuccess) { fprintf(stderr, "kernel_launch: hipFuncSetAttribute failed\n"); grid = -1; return; }
        if (hipOccupancyMaxActiveBlocksPerMultiprocessor(&per_cu, (const void*)fwd_kernel, NTHREADS, LDS_BYTES) != hipSuccess || per_cu < 1) { fprintf(stderr, "kernel_launch: occupancy query says %d\n", per_cu); (void)hipGetLastError(); }
        grid = cus;
        if (grid > 256) grid = 256;
    }
    if (grid < 0) return;
    (void)hipMemsetAsync((char*)d_ws + WS_CTL, 0, CTL_ZERO_BYTES, stream);
    Args a{};
    for (int i = 0; i < 20; ++i) a.in[i] = (const float*)d_in[i];
    a.out = (float*)d_out; a.ws = (unsigned char*)d_ws;
#if MK_PER_PHASE
    a.sub = 3;
    for (int p = 0; p < NPHASES; ++p) { a.ph_lo = p; a.ph_hi = p + 1; hipLaunchKernelGGL(fwd_kernel, dim3(grid), dim3(NTHREADS), LDS_BYTES, stream, a); }
#else
#ifdef PROBE_REPEAT
#ifndef PROBE_SUB
#define PROBE_SUB 3
#endif
    a.ph_lo = 0; a.ph_hi = PROBE_REPEAT + 1; a.sub = 3;
#ifdef PROBE_VAR
    a.pad = PROBE_VAR;
#endif
    { void* kargs[] = {(void*)&a}; (void)hipLaunchCooperativeKernel((const void*)fwd_kernel, dim3(grid), dim3(NTHREADS), kargs, LDS_BYTES, stream); }
    (void)hipMemsetAsync((char*)d_ws + WS_CTL, 0, CTL_ZERO_BYTES, stream);
    a.ph_lo = PROBE_REPEAT; a.ph_hi = NPHASES; a.sub = PROBE_SUB; a.pad = 0;
    { void* kargs[] = {(void*)&a}; (void)hipLaunchCooperativeKernel((const void*)fwd_kernel, dim3(grid), dim3(NTHREADS), kargs, LDS_BYTES, stream); }
#else
    a.ph_lo = 0; a.ph_hi = NPHASES; a.sub = 3;
    void* kargs[] = {(void*)&a};
    hipError_t e = hipLaunchCooperativeKernel((const void*)fwd_kernel, dim3(grid), dim3(NTHREADS), kargs, LDS_BYTES, stream);
    if (e != hipSuccess) { fprintf(stderr, "kernel_launch: cooperative launch failed: %s\n", hipGetErrorString(e)); (void)hipGetLastError();
        hipLaunchKernelGGL(fwd_kernel, dim3(grid), dim3(NTHREADS), LDS_BYTES, stream, a); }
#endif
#endif
}
```

```cpp
#include <hip/hip_runtime.h>
#include <cstdio>
#include <cstdint>

#define LAS __attribute__((address_space(3)))
#define GAS __attribute__((address_space(1)))
typedef unsigned short bf16_t;
typedef short bf16x8 __attribute__((ext_vector_type(8)));
typedef short s16x4 __attribute__((ext_vector_type(4)));
typedef float f32x2 __attribute__((ext_vector_type(2)));
typedef float f32x4 __attribute__((ext_vector_type(4)));
typedef float f32x16 __attribute__((ext_vector_type(16)));
typedef int i32x8 __attribute__((ext_vector_type(8)));
typedef int i32x4 __attribute__((ext_vector_type(4)));
typedef short bf16x16 __attribute__((ext_vector_type(16)));
typedef unsigned u32x2 __attribute__((ext_vector_type(2)));
typedef unsigned u32x4 __attribute__((ext_vector_type(4)));
typedef GAS unsigned gu32;

constexpr int NB = 8, SEQ = 8192, DM = 1024, NTOK = NB * SEQ;
constexpr int NPROJ = 3584;
constexpr int NEXP = 32;
constexpr int MOE_ROWS = (NTOK * 2 / 256 + NEXP) * 256;
constexpr float EPS = 1e-6f;
constexpr int NTHREADS = 512, NWAVES = 8;

constexpr size_t MiB = 1u << 20;
constexpr size_t WS_CTL = 0, CTL_ZERO_BYTES = 1 * MiB;
constexpr size_t WS_MOD = 1 * MiB;
constexpr size_t WS_GATES = 2 * MiB;
constexpr size_t WS_BCUM = 4 * MiB;
constexpr size_t WS_AVAL = 5 * MiB;
constexpr size_t WS_SCINFO = 6 * MiB;
constexpr size_t WS_NLOC = 6 * MiB + 65536;
constexpr size_t WS_NST = 14 * MiB;
constexpr size_t WS_SCW = 14 * MiB + 524288;
constexpr size_t WS_POSOF = 15 * MiB;
constexpr size_t WS_KMEAN = 7 * MiB;
constexpr size_t WS_SEL = 8 * MiB;
constexpr size_t WS_EID = 10 * MiB;
constexpr size_t WS_EW = 10 * MiB + 512 * 1024;
constexpr size_t WS_BCNT = 11 * MiB;
constexpr size_t WS_NTILES = 11 * MiB + 32768;
constexpr size_t WS_TILEE = 11 * MiB + 65536;
constexpr size_t WS_ROWTOK = 12 * MiB;
constexpr size_t WS_ROWW = 13 * MiB;
constexpr size_t WS_HN2 = 122 * MiB;
constexpr size_t WS_X1B = 218 * MiB;
constexpr size_t WS_W1T = 16 * MiB;
constexpr size_t WS_WOT = 23 * MiB;
constexpr size_t WS_WGU = 26 * MiB;
constexpr size_t WS_WD = 90 * MiB;
constexpr size_t WS_CST = 122 * MiB;
constexpr size_t WS_CLOC = 154 * MiB;
constexpr size_t WS_HN = 218 * MiB;
constexpr size_t WS_QC = 218 * MiB;
constexpr size_t WS_KC = 282 * MiB;
constexpr size_t WS_QA = 346 * MiB;
constexpr size_t WS_VM = 666 * MiB;
constexpr size_t HM_SEC = (size_t)NTOK * 512;
constexpr size_t WS_XS = 346 * MiB;
constexpr size_t WS_HB = 618 * MiB;
constexpr size_t WS_YS = 346 * MiB;
constexpr size_t WS_HCAT = 794 * MiB;
constexpr size_t WS_VTA = 922 * MiB;
constexpr size_t WS_END = 1010 * MiB;
constexpr size_t DO_SLOTS = 0;
constexpr size_t DO_ML = 192 * MiB;

constexpr int LDS_BYTES = 155648;
constexpr int MISC_OFF = 150 * 1024;

__device__ __forceinline__ float bf2f(unsigned u16) { return __uint_as_float(u16 << 16); }
__device__ __forceinline__ unsigned f2bf(float f) { unsigned u = __float_as_uint(f); return (u + 0x7fffu + ((u >> 16) & 1u)) >> 16; }
typedef __bf16 bf16x2_t __attribute__((ext_vector_type(2)));
__device__ __forceinline__ unsigned pk2(float lo, float hi) { const f32x2 v = {lo, hi}; return __builtin_bit_cast(unsigned, __builtin_convertvector(v, bf16x2_t)); }
__device__ __forceinline__ unsigned pk4_fp8(float a, float b, float c, float d) { int v = __builtin_amdgcn_cvt_pk_fp8_f32(a, b, 0, false); v = __builtin_amdgcn_cvt_pk_fp8_f32(c, d, v, true); return (unsigned)v; }
__device__ __forceinline__ float lo16(unsigned w) { return __uint_as_float(w << 16); }
__device__ __forceinline__ float hi16(unsigned w) { return __uint_as_float(w & 0xffff0000u); }
__device__ __forceinline__ void unpack8(const u32x4 v, float* f) {
    f[0] = lo16(v.x); f[1] = hi16(v.x); f[2] = lo16(v.y); f[3] = hi16(v.y); f[4] = lo16(v.z); f[5] = hi16(v.z); f[6] = lo16(v.w); f[7] = hi16(v.w);
}
__device__ __forceinline__ float wave_sum(float v) {
#pragma unroll
    for (int o = 1; o < 64; o <<= 1) v += __shfl_xor(v, o);
    return v;
}
__device__ __forceinline__ float wave_max(float v) {
#pragma unroll
    for (int o = 1; o < 64; o <<= 1) v = fmaxf(v, __shfl_xor(v, o));
    return v;
}
__device__ __forceinline__ float silu_f(float v) { return v * __builtin_amdgcn_rcpf(1.0f + __builtin_amdgcn_exp2f(-1.4426950408889634f * v)); }
__device__ __forceinline__ float fexp(float v) { return __builtin_amdgcn_exp2f(1.4426950408889634f * v); }
__device__ __forceinline__ int fresh_lane() { int l; asm volatile("v_mbcnt_lo_u32_b32 %0, -1, 0\n\tv_mbcnt_hi_u32_b32 %0, -1, %0" : "=v"(l)); return l; }
#define LDS_WAIT() asm volatile("s_waitcnt lgkmcnt(0)" ::: "memory")
#define VM_WAIT() asm volatile("s_waitcnt vmcnt(0)" ::: "memory")

#define XB_TMO      128
#define XB_XCNT(j)  (256  + 64 * (j))
#define XB_XSUB(j)  (1280 + 64 * (j))
#define XB_XGEN(j)  (2304 + 64 * (j))
#define XB_TOP      3328
#define XB_TOPGEN   3392
#define XCD_BAR_WORDS 3456
#define XB_SPIN_CAP (1u << 20)
constexpr int CW_BAR = 4096;

__device__ __forceinline__ unsigned xb_ld(unsigned* p)              { return __hip_atomic_load(p, __ATOMIC_RELAXED, __HIP_MEMORY_SCOPE_AGENT); }
__device__ __forceinline__ unsigned xb_add(unsigned* p, unsigned v) { return __hip_atomic_fetch_add(p, v, __ATOMIC_RELAXED, __HIP_MEMORY_SCOPE_AGENT); }
__device__ __forceinline__ unsigned xb_xcc_id() { return (unsigned)__builtin_amdgcn_s_getreg((3 << 11) | 20) & 0xFu; }
#define XB_SPIN(cond, bar) do { unsigned _sp = 0; while (cond) { __builtin_amdgcn_s_sleep(1); \
    if ((++_sp & 255u) == 0u) { if (xb_ld(&(bar)[XB_TMO])) break; if (_sp > XB_SPIN_CAP) { atomicAdd(&(bar)[XB_TMO], 1u); break; } } } } while (0)

struct XcdBarrier { unsigned* bar; unsigned x; volatile LAS unsigned* st; };

__device__ __forceinline__ XcdBarrier xcd_barrier_post(unsigned* bar, volatile LAS unsigned* st) {
    XcdBarrier b; b.bar = bar; b.x = xb_xcc_id(); b.st = st;
    if (threadIdx.x == 0) (void)xb_add(&bar[XB_XCNT(b.x)], 1u);
    return b;
}
__device__ __forceinline__ void xcd_barrier_complete(unsigned* bar, unsigned x, unsigned& nloc, unsigned& nx) {
    const unsigned G = gridDim.x * gridDim.y * gridDim.z;
    unsigned sum, cnt, mine, sp = 0u;
    for (;;) {
        sum = 0u; cnt = 0u; mine = 0u;
#pragma unroll
        for (unsigned j = 0; j < 16; ++j) { const unsigned c = xb_ld(&bar[XB_XCNT(j)]); sum += c; cnt += (c > 0u) ? 1u : 0u; mine = (j == x) ? c : mine; }
        if (sum == G) break;
        __builtin_amdgcn_s_sleep(1);
        if ((++sp & 255u) == 0u) { if (xb_ld(&bar[XB_TMO])) break; if (sp > XB_SPIN_CAP) { atomicAdd(&bar[XB_TMO], 1u); break; } }
    }
    nloc = mine > 0u ? mine : 1u; nx = cnt > 0u ? cnt : 1u;
}
__device__ __forceinline__ void xcd_barrier(const XcdBarrier& b, bool leader) {
    asm volatile("s_waitcnt vmcnt(0)" ::: "memory");
    __syncthreads();
    if (leader) {
        unsigned* bar = b.bar;
        __builtin_amdgcn_s_waitcnt(0);
        unsigned nloc = b.st[0], nx = b.st[1];
        if (nloc == 0u) { xcd_barrier_complete(bar, b.x, nloc, nx); b.st[0] = nloc; b.st[1] = nx; }
        const unsigned old = xb_add(&bar[XB_XSUB(b.x)], 1u);
        const unsigned gen = old / nloc;
        if (old + 1u == (gen + 1u) * nloc) {
            __builtin_amdgcn_fence(__ATOMIC_RELEASE, "agent");
            asm volatile("s_waitcnt vmcnt(0)" ::: "memory");
            const unsigned og = xb_add(&bar[XB_TOP], 1u);
            const unsigned tg = og / nx;
            if (og + 1u == (tg + 1u) * nx) xb_add(&bar[XB_TOPGEN], 1u);
            else XB_SPIN(xb_ld(&bar[XB_TOPGEN]) == tg, bar);
            __builtin_amdgcn_fence(__ATOMIC_ACQUIRE, "agent");
            xb_add(&bar[XB_XGEN(b.x)], 1u);
            asm volatile("s_waitcnt vmcnt(0)" ::: "memory");
        } else {
            XB_SPIN(xb_ld(&bar[XB_XGEN(b.x)]) == gen, bar);
            __builtin_amdgcn_fence(__ATOMIC_ACQUIRE, "agent");
            asm volatile("s_waitcnt vmcnt(0)" ::: "memory");
        }
    }
    __syncthreads();
}

namespace pg8 {
constexpr int BM = 256, BK = 64, HALF = 128, HTB = HALF * BK * 2, STAGE_BYTES = 8 * HTB, NXCD = 8, WGM = 8;
__device__ __forceinline__ int lds_byte(int r, int c) { const int st = (r >> 4) * 2 + (c >> 5), rr = r & 15, cc = c & 31, ob = rr * 64 + cc * 2; return st * 1024 + (ob ^ (((ob >> 9) & 1) << 5)); }
__device__ __forceinline__ void stage_rc(int b, int& R, int& C) { const int st = b / 1024, sb = b % 1024, swz = sb ^ (((sb >> 9) & 1) << 5); R = (st >> 1) * 16 + swz / 64; C = (st & 1) * 32 + (swz % 64) / 2; }
__device__ __forceinline__ int perm32(int rho) { const int n = rho >> 4, i = rho & 15; return 8 * (i >> 2) + 4 * n + (i & 3); }

struct Unit { int pm, pn; const char* a; const char* b; };

struct DenseOrder {
    int nM, nN, nwg, G, c; const char* A; const char* Bt; size_t tstep;
    __device__ __forceinline__ void init(const void* A_, const void* Bt_, int M, int N, int K, int G_, int c_) { A = (const char*)A_; Bt = (const char*)Bt_; nM = M / BM; nN = N / BM; nwg = nM * nN; G = G_; c = c_; tstep = (size_t)BM * K * 2; }
    __device__ __forceinline__ bool next(int i, Unit& u) const {
        const long L = (long)i * G + c; if (L >= nwg) return false;
        int wgid = (int)L; { const int q = nwg / NXCD, r = nwg % NXCD, xcd = wgid % NXCD, off = wgid / NXCD; wgid = (xcd < r ? xcd * (q + 1) : r * (q + 1) + (xcd - r) * q) + off; }
        const int nig = WGM * nN, gid = wgid / nig, fm = gid * WGM, gsz = (nM - fm) < WGM ? (nM - fm) : WGM;
        u.pm = fm + ((wgid % nig) % gsz); u.pn = (wgid % nig) / gsz; u.a = A + (size_t)u.pm * tstep; u.b = Bt + (size_t)u.pn * tstep; return true;
    }
};
struct RowMajorOrder {
    int nM, nN, G, v; const char* A; const char* Bt; size_t tstep;
    __device__ __forceinline__ void init(const void* A_, const void* Bt_, int M, int N, int K, int G_, int v_) { A = (const char*)A_; Bt = (const char*)Bt_; nM = M / BM; nN = N / BM; G = G_; v = v_; tstep = (size_t)BM * K * 2; }
    __device__ __forceinline__ bool next(int i, Unit& u) const {
        const int pm = v + (i / nN) * G; if (pm >= nM) return false;
        u.pm = pm; u.pn = i % nN; u.a = A + (size_t)u.pm * tstep; u.b = Bt + (size_t)u.pn * tstep; return true;
    }
};
struct MoeOrder {
    const int* tile_e; int nunits, G, vcu; const char* A; const char* Bt; size_t a_tile, b_exp, b_tile;
    __device__ __forceinline__ bool next(int i, Unit& u) const {
        const long L = (long)i * G + vcu; if (L >= nunits) return false;
        const int rt = (int)(L >> 2), pn = (int)(L & 3); const int e = __builtin_amdgcn_readfirstlane(tile_e[rt]);
        u.pm = rt; u.pn = pn; u.a = A + (size_t)rt * a_tile; u.b = Bt + (size_t)e * b_exp + (size_t)pn * b_tile; return true;
    }
};

__device__ __forceinline__ unsigned cvt_pk_bf16(float lo, float hi) { unsigned r; asm volatile("v_cvt_pk_bf16_f32 %0, %1, %2" : "=v"(r) : "v"(lo), "v"(hi)); return r; }

struct EpiBf16 {
    static constexpr bool PERM = true;
    bf16_t* O; int ldc;
    __device__ __forceinline__ void operator()(const f32x4 (&acc)[2][2][4][2], const Unit& u, int wr, int wc, int fr, int fq) const {
        const int row0 = u.pm * BM + wr * 64 + fr; const int col0 = u.pn * BM + wc * 32 + 8 * fq;
#pragma unroll
        for (int ai = 0; ai < 2; ++ai)
#pragma unroll
            for (int m = 0; m < 4; ++m) { bf16_t* rowp = O + (size_t)(row0 + ai * HALF + m * 16) * ldc + col0;
#pragma unroll
                for (int bj = 0; bj < 2; ++bj) { const f32x4 v0 = acc[ai][bj][m][0], v1 = acc[ai][bj][m][1];
                    u32x4 w; w.x = cvt_pk_bf16(v0[0], v0[1]); w.y = cvt_pk_bf16(v0[2], v0[3]); w.z = cvt_pk_bf16(v1[0], v1[1]); w.w = cvt_pk_bf16(v1[2], v1[3]);
                    *(u32x4*)(rowp + bj * HALF) = w; } }
    }
};
struct EpiProj {
    static constexpr bool PERM = true;
    bf16_t* HM; bf16_t* VM;
    __device__ __forceinline__ void operator()(const f32x4 (&acc)[2][2][4][2], const Unit& u, int wr, int wc, int fr, int fq) const {
        const int b = u.pm >> 5, t0 = (u.pm & 31) * BM + wr * 64 + fr;
        bf16_t* base; size_t rstep, bstep;
        if (u.pn >= 4 && u.pn < 8) { const int sec = (u.pn - 4) >> 1, h0 = (u.pn & 1) * 2;
            base = VM + (size_t)sec * ((size_t)NTOK * 512) + ((size_t)(b * 4 + h0) * SEQ + t0) * 128 + wc * 32 + 8 * fq; rstep = 16 * 128; bstep = (size_t)SEQ * 128; }
        else { const int sec = (u.pn < 4) ? 3 + (u.pn >> 1) : (u.pn - 8) >> 1, g0 = (u.pn & 1) * 4 + (wc >> 1);
            base = HM + (size_t)sec * ((size_t)NTOK * 512) + ((size_t)(b * 8 + g0) * SEQ + t0) * 64 + (wc & 1) * 32 + 8 * fq; rstep = 16 * 64; bstep = (size_t)2 * SEQ * 64; }
#pragma unroll
        for (int ai = 0; ai < 2; ++ai)
#pragma unroll
            for (int m = 0; m < 4; ++m) { bf16_t* rowp = base + (size_t)(ai * 8 + m) * rstep;
#pragma unroll
                for (int bj = 0; bj < 2; ++bj) { const f32x4 v0 = acc[ai][bj][m][0], v1 = acc[ai][bj][m][1];
                    u32x4 w; w.x = cvt_pk_bf16(v0[0], v0[1]); w.y = cvt_pk_bf16(v0[2], v0[3]); w.z = cvt_pk_bf16(v1[0], v1[1]); w.w = cvt_pk_bf16(v1[2], v1[3]);
                    *(u32x4*)(rowp + bj * bstep) = w; } }
    }
};
struct EpiRes {
    static constexpr bool PERM = true;
    const float* x; bf16_t* out; const float* gate;
    __device__ __forceinline__ void operator()(const f32x4 (&acc)[2][2][4][2], const Unit& u, int wr, int wc, int fr, int fq) const {
        const int col0 = u.pn * BM + wc * 32 + 8 * fq; const float* gp = gate + (size_t)(u.pm >> 5) * 6144 + col0;
        f32x4 gv[2][2];
#pragma unroll
        for (int bj = 0; bj < 2; ++bj)
#pragma unroll
            for (int n = 0; n < 2; ++n) gv[bj][n] = *(const f32x4*)(gp + bj * HALF + n * 4);
#pragma unroll
        for (int ai = 0; ai < 2; ++ai)
#pragma unroll
            for (int m = 0; m < 4; ++m) { const size_t off = (size_t)(u.pm * BM + ai * HALF + wr * 64 + m * 16 + fr) * DM + col0;
#pragma unroll
                for (int bj = 0; bj < 2; ++bj) { const f32x4 x0 = *(const f32x4*)(x + off + bj * HALF), x1 = *(const f32x4*)(x + off + bj * HALF + 4);
                    const f32x4 v0 = x0 + gv[bj][0] * acc[ai][bj][m][0], v1 = x1 + gv[bj][1] * acc[ai][bj][m][1];
                    u32x4 w; w.x = cvt_pk_bf16(v0[0], v0[1]); w.y = cvt_pk_bf16(v0[2], v0[3]); w.z = cvt_pk_bf16(v1[0], v1[1]); w.w = cvt_pk_bf16(v1[2], v1[3]);
                    *(u32x4*)(out + off + bj * HALF) = w; } }
    }
};
struct EpiSwiglu {
    static constexpr bool PERM = true;
    bf16_t* H;
    __device__ __forceinline__ void operator()(const f32x4 (&acc)[2][2][4][2], const Unit& u, int wr, int wc, int fr, int fq) const {
        const int row0 = u.pm * BM + wr * 64 + fr; const int col0 = u.pn * HALF + wc * 32 + 8 * fq;
#pragma unroll
        for (int ai = 0; ai < 2; ++ai)
#pragma unroll
            for (int m = 0; m < 4; ++m) { float h[8];
#pragma unroll
                for (int n = 0; n < 2; ++n)
#pragma unroll
                    for (int j = 0; j < 4; ++j) { const float g = acc[ai][0][m][n][j], up = acc[ai][1][m][n][j]; h[n * 4 + j] = g * __builtin_amdgcn_rcpf(1.0f + __builtin_amdgcn_exp2f(-1.4426950408889634f * g)) * up; }
                u32x4 w; w.x = cvt_pk_bf16(h[0], h[1]); w.y = cvt_pk_bf16(h[2], h[3]); w.z = cvt_pk_bf16(h[4], h[5]); w.w = cvt_pk_bf16(h[6], h[7]);
                *(u32x4*)(H + (size_t)(row0 + ai * HALF + m * 16) * 512 + col0) = w; }
    }
};
struct EpiSwigluF8 {
    static constexpr bool PERM = true;
    unsigned char* H;
    __device__ __forceinline__ void operator()(const f32x4 (&acc)[2][2][4][2], const Unit& u, int wr, int wc, int fr, int fq) const {
        const int row0 = u.pm * BM + wr * 64 + fr; const int col0 = u.pn * HALF + wc * 32 + 8 * fq;
#pragma unroll
        for (int ai = 0; ai < 2; ++ai)
#pragma unroll
            for (int m = 0; m < 4; ++m) { float h[8];
#pragma unroll
                for (int n = 0; n < 2; ++n)
#pragma unroll
                    for (int j = 0; j < 4; ++j) { const float g = acc[ai][0][m][n][j], up = acc[ai][1][m][n][j]; h[n * 4 + j] = g * __builtin_amdgcn_rcpf(1.0f + __builtin_amdgcn_exp2f(-1.4426950408889634f * g)) * up; }
                *(u32x2*)(H + (size_t)(row0 + ai * HALF + m * 16) * 512 + col0) = (u32x2){pk4_fp8(h[0], h[1], h[2], h[3]), pk4_fp8(h[4], h[5], h[6], h[7])}; }
    }
};
struct EpiF8 {
    static constexpr bool PERM = true;
    unsigned char* O; int ldc;
    __device__ __forceinline__ void operator()(const f32x4 (&acc)[2][2][4][2], const Unit& u, int wr, int wc, int fr, int fq) const {
        const int row0 = u.pm * BM + wr * 64 + fr; const int col0 = u.pn * BM + wc * 32 + 8 * fq;
#pragma unroll
        for (int ai = 0; ai < 2; ++ai)
#pragma unroll
            for (int m = 0; m < 4; ++m) { unsigned char* rowp = O + (size_t)(row0 + ai * HALF + m * 16) * ldc + col0;
#pragma unroll
                for (int bj = 0; bj < 2; ++bj) { const f32x4 v0 = acc[ai][bj][m][0], v1 = acc[ai][bj][m][1];
                    *(u32x2*)(rowp + bj * HALF) = (u32x2){pk4_fp8(v0[0], v0[1], v0[2], v0[3]), pk4_fp8(v1[0], v1[1], v1[2], v1[3])}; } }
    }
};
struct EpiScatter {
    static constexpr bool PERM = true;
    bf16_t* Y; const int* rowtok; const float* roww;
    __device__ __forceinline__ void operator()(const f32x4 (&acc)[2][2][4][2], const Unit& u, int wr, int wc, int fr, int fq) const {
        const int row0 = u.pm * BM + wr * 64 + fr; const int col0 = u.pn * BM + wc * 32 + 8 * fq;
#pragma unroll
        for (int ai = 0; ai < 2; ++ai)
#pragma unroll
            for (int m = 0; m < 4; ++m) { const int r = row0 + ai * HALF + m * 16; const int rt = rowtok[r]; const float w = roww[r];
                if (rt >= 0) { bf16_t* rowp = Y + (size_t)rt * DM + col0;
#pragma unroll
                    for (int bj = 0; bj < 2; ++bj) { const f32x4 v0 = acc[ai][bj][m][0] * w, v1 = acc[ai][bj][m][1] * w;
                        u32x4 o; o.x = cvt_pk_bf16(v0[0], v0[1]); o.y = cvt_pk_bf16(v0[2], v0[3]); o.z = cvt_pk_bf16(v1[0], v1[1]); o.w = cvt_pk_bf16(v1[2], v1[3]);
                        *(u32x4*)(rowp + bj * HALF) = o; } } }
    }
};

template <int K, class Epi, class Sched, bool ALIGN_EPI, bool GATHER = false>
__device__ __forceinline__ void gemm_phase(LAS unsigned char* lds, const Sched& S, const Epi& E, int wid, const int* rows = nullptr) {
    const int lane = fresh_lane(), tid = wid * 64 + lane, wr = wid >> 2, wc = wid & 3, fr = lane & 15, fq = lane >> 4;
    constexpr int nt = K / BK;
    unsigned voffA[2][2], voffN[2][2], voffB[2];
    int Rr[2], Cc[2];
#pragma unroll
    for (int i = 0; i < 2; ++i) { int R, C; stage_rc(tid * 16 + i * 8192, R, C); const int Rb = Epi::PERM ? ((R & ~31) + perm32(R & 31)) : R; Rr[i] = R; Cc[i] = C;
        voffA[0][i] = (unsigned)(R * K + C) * 2u; voffA[1][i] = 0u; voffB[i] = (unsigned)(Rb * K + C) * 2u; }
    constexpr size_t kstep = (size_t)(BK * 2);
    constexpr size_t hstep = (size_t)HALF * K * 2;
    const unsigned ldsw = (unsigned)wid * 1024u;
    const int aoff = lds_byte(wr * 64 + fr, fq * 8), boff = lds_byte(wc * 32 + fr, fq * 8);
#define PG8_SA(b, h) (((b) * 2 + (h)) * HTB)
#define PG8_SB(b, h) ((4 + (b) * 2 + (h)) * HTB)
#define PG8_STAGE(bufoff, gbase, voff) do { _Pragma("unroll") for (int _i = 0; _i < 2; ++_i) \
        __builtin_amdgcn_global_load_lds((const unsigned*)((const char*)(gbase) + (voff)[_i]), (LAS unsigned*)(lds + (bufoff) + ldsw + _i * 8192), 16, 0, 0); } while (0)
#define PG8_STAGE_A1(bufoff, gbase, voff2) do { _Pragma("unroll") for (int _i = 0; _i < 2; ++_i) \
        __builtin_amdgcn_global_load_lds((const unsigned*)((const char*)(gbase) + (GATHER ? (size_t)0 : hstep) + (GATHER ? (voff2)[1][_i] : (voff2)[0][_i])), (LAS unsigned*)(lds + (bufoff) + ldsw + _i * 8192), 16, 0, 0); } while (0)
#define PG8_LDA(dst, b, h) do { _Pragma("unroll") for (int m = 0; m < 4; ++m) _Pragma("unroll") for (int k = 0; k < 2; ++k) dst[m][k] = *(const LAS bf16x8*)(lds + PG8_SA(b, h) + aoff + m * 2048 + k * 1024); } while (0)
#define PG8_LDB(dst, b, h) do { _Pragma("unroll") for (int n = 0; n < 2; ++n) _Pragma("unroll") for (int k = 0; k < 2; ++k) dst[n][k] = *(const LAS bf16x8*)(lds + PG8_SB(b, h) + boff + n * 2048 + k * 1024); } while (0)
#define PG8_MMA(ai, bj, At, Bt) do { __builtin_amdgcn_s_setprio(1); _Pragma("unroll") for (int m = 0; m < 4; ++m) _Pragma("unroll") for (int n = 0; n < 2; ++n) _Pragma("unroll") for (int k = 0; k < 2; ++k) \
        acc[ai][bj][m][n] = __builtin_amdgcn_mfma_f32_16x16x32_bf16(Bt[n][k], At[m][k], acc[ai][bj][m][n], 0, 0, 0); __builtin_amdgcn_s_setprio(0); } while (0)
#define PG8_WAIT_V(n) asm volatile("s_waitcnt vmcnt(" #n ")" ::: "memory")
#define PG8_WAIT_L(n) asm volatile("s_waitcnt lgkmcnt(" #n ")" ::: "memory")
#define PG8_BAR __builtin_amdgcn_s_barrier()
#define PG8_SCHED __builtin_amdgcn_sched_barrier(0)
    Unit cur, nxt; int ui = 0;
    if (!S.next(0, cur)) return;
    f32x4 acc[2][2][4][2];
#pragma unroll
    for (int a = 0; a < 2; ++a)
#pragma unroll
        for (int b = 0; b < 2; ++b)
#pragma unroll
            for (int m = 0; m < 4; ++m)
#pragma unroll
                for (int n = 0; n < 2; ++n) acc[a][b][m][n] = (f32x4){0.f, 0.f, 0.f, 0.f};
    bf16x8 At[4][2], B0[2][2], B1[2][2];
    const char* cA = cur.a; const char* cB = cur.b;
    if constexpr (GATHER) {
#pragma unroll
        for (int h = 0; h < 2; ++h)
#pragma unroll
            for (int i = 0; i < 2; ++i) voffA[h][i] = (unsigned)rows[cur.pm * BM + h * HALF + Rr[i]] * (unsigned)(K * 2) + (unsigned)Cc[i] * 2u; }
    PG8_STAGE(PG8_SB(0, 0), cB, voffB); PG8_STAGE(PG8_SB(0, 1), cB + hstep, voffB); PG8_STAGE(PG8_SA(0, 0), cA, voffA[0]); PG8_STAGE_A1(PG8_SA(0, 1), cA, voffA);
    if (wr == 1) PG8_BAR;
    PG8_WAIT_V(2); PG8_BAR;
    PG8_STAGE(PG8_SB(1, 0), cB + kstep, voffB); PG8_STAGE(PG8_SA(1, 0), cA + kstep, voffA[0]); PG8_STAGE(PG8_SB(1, 1), cB + hstep + kstep, voffB);
    PG8_WAIT_V(6); PG8_BAR;
    for (;;) {
        const bool has_next = S.next(ui + 1, nxt);
        const char* nA = has_next ? nxt.a : cA; const char* nB = has_next ? nxt.b : cB;
        if constexpr (GATHER) {
            const int npm = has_next ? nxt.pm : cur.pm;
#pragma unroll
            for (int h = 0; h < 2; ++h)
#pragma unroll
                for (int i = 0; i < 2; ++i) voffN[h][i] = (unsigned)rows[npm * BM + h * HALF + Rr[i]] * (unsigned)(K * 2) + (unsigned)Cc[i] * 2u; }
        for (int t = 0; t < nt; t += 2) {
            const bool last = (t == nt - 2);
            unsigned vs[2][2];
#pragma unroll
            for (int h = 0; h < 2; ++h)
#pragma unroll
                for (int i = 0; i < 2; ++i) vs[h][i] = (GATHER && last) ? voffN[h][i] : voffA[h][i];
            const char* a1 = cA + (size_t)(t + 1) * kstep;
            const char* a2 = last ? nA : cA + (size_t)(t + 2) * kstep; const char* b2 = last ? nB : cB + (size_t)(t + 2) * kstep;
            const char* a3 = a2 + kstep; const char* b3 = b2 + kstep;
            PG8_LDB(B0, 0, 0); PG8_LDB(B1, 0, 1); PG8_SCHED; PG8_LDA(At, 0, 0); PG8_STAGE_A1(PG8_SA(1, 1), a1, voffA);
            PG8_WAIT_V(8); PG8_WAIT_L(0); PG8_BAR; PG8_MMA(0, 0, At, B0); PG8_MMA(0, 1, At, B1); PG8_BAR; PG8_SCHED;
            PG8_LDA(At, 0, 1); PG8_STAGE(PG8_SB(0, 0), b2, voffB); PG8_STAGE(PG8_SB(0, 1), b2 + hstep, voffB); PG8_STAGE(PG8_SA(0, 0), a2, vs[0]);
            PG8_WAIT_V(8); PG8_WAIT_L(0); PG8_BAR; PG8_MMA(1, 0, At, B0); PG8_MMA(1, 1, At, B1); PG8_BAR; PG8_SCHED;
            PG8_LDB(B0, 1, 0); PG8_LDB(B1, 1, 1); PG8_SCHED; PG8_LDA(At, 1, 0); PG8_STAGE_A1(PG8_SA(0, 1), a2, vs);
            PG8_WAIT_V(8); PG8_WAIT_L(0); PG8_BAR; PG8_MMA(0, 0, At, B0); PG8_MMA(0, 1, At, B1); PG8_BAR; PG8_SCHED;
            PG8_LDA(At, 1, 1); PG8_STAGE(PG8_SB(1, 0), b3, voffB); PG8_STAGE(PG8_SB(1, 1), b3 + hstep, voffB); PG8_STAGE(PG8_SA(1, 0), a3, vs[0]);
            PG8_WAIT_V(8); PG8_WAIT_L(0); PG8_BAR; PG8_MMA(1, 0, At, B0); PG8_MMA(1, 1, At, B1); PG8_BAR; PG8_SCHED;
        }
        if constexpr (ALIGN_EPI) { if (wr == 0) PG8_BAR; }
        E(acc, cur, wr, wc, fr, fq);
        if (!has_next) break;
#pragma unroll
        for (int a = 0; a < 2; ++a)
#pragma unroll
            for (int b = 0; b < 2; ++b)
#pragma unroll
                for (int m = 0; m < 4; ++m)
#pragma unroll
                    for (int n = 0; n < 2; ++n) acc[a][b][m][n] = (f32x4){0.f, 0.f, 0.f, 0.f};
        cur = nxt; cA = nA; cB = nB; ++ui;
        if constexpr (GATHER) {
#pragma unroll
            for (int h = 0; h < 2; ++h)
#pragma unroll
                for (int i = 0; i < 2; ++i) voffA[h][i] = voffN[h][i]; }
        if constexpr (ALIGN_EPI) { if (wr == 1) PG8_BAR; }
    }
    PG8_WAIT_V(0);
    if constexpr (!ALIGN_EPI) { if (wr == 0) PG8_BAR; }
    PG8_BAR;
#undef PG8_SA
#undef PG8_SB
#undef PG8_STAGE
#undef PG8_STAGE_A1
#undef PG8_LDA
#undef PG8_LDB
#undef PG8_MMA
#undef PG8_WAIT_V
#undef PG8_WAIT_L
#undef PG8_BAR
#undef PG8_SCHED
}
template <int K, class Epi, class Sched, bool ALIGN_EPI, bool GATHER, int SCALE_W>
__device__ __forceinline__ void gemm_phase_fp8(LAS unsigned char* lds, const Sched& S, const Epi& E, int wid, const int* rows) {
    const int lane = fresh_lane(), tid = wid * 64 + lane, wr = wid >> 2, wc = wid & 3, fr = lane & 15, fq = lane >> 4;
    constexpr int nt = K / 128;
    unsigned voffA[2][2], voffN[2][2], voffB[2];
#pragma unroll
    for (int i = 0; i < 2; ++i) { int R, C; stage_rc(tid * 16 + i * 8192, R, C); const int Rb = Epi::PERM ? ((R & ~31) + perm32(R & 31)) : R;
        voffA[0][i] = (unsigned)(R * K + C * 2); voffA[1][i] = 0u; voffB[i] = (unsigned)(Rb * K + C * 2); }
    constexpr size_t kstep = (size_t)(BK * 2);
    constexpr size_t hstep = (size_t)HALF * K;
    const unsigned ldsw = (unsigned)wid * 1024u;
    const int aoff = lds_byte(wr * 64 + fr, fq * 16), boff = lds_byte(wc * 32 + fr, fq * 16);
#define PG8_SA(b, h) (((b) * 2 + (h)) * HTB)
#define PG8_SB(b, h) ((4 + (b) * 2 + (h)) * HTB)
#define PG8_STAGE(bufoff, gbase, voff) do { _Pragma("unroll") for (int _i = 0; _i < 2; ++_i) \
        __builtin_amdgcn_global_load_lds((const unsigned*)((const char*)(gbase) + (voff)[_i]), (LAS unsigned*)(lds + (bufoff) + ldsw + _i * 8192), 16, 0, 0); } while (0)
#define PG8_STAGE_A1(bufoff, gbase, voff2) do { _Pragma("unroll") for (int _i = 0; _i < 2; ++_i) \
        __builtin_amdgcn_global_load_lds((const unsigned*)((const char*)(gbase) + (GATHER ? (size_t)0 : hstep) + (GATHER ? (voff2)[1][_i] : (voff2)[0][_i])), (LAS unsigned*)(lds + (bufoff) + ldsw + _i * 8192), 16, 0, 0); } while (0)
#define PG8_LDA(dst, b, h) do { _Pragma("unroll") for (int m = 0; m < 4; ++m) { const i32x4 lo_ = *(const LAS i32x4*)(lds + PG8_SA(b, h) + aoff + m * 2048), hi_ = *(const LAS i32x4*)(lds + PG8_SA(b, h) + (aoff ^ 16) + m * 2048); dst[m] = __builtin_shufflevector(lo_, hi_, 0, 1, 2, 3, 4, 5, 6, 7); } } while (0)
#define PG8_LDB(dst, b, h) do { _Pragma("unroll") for (int n = 0; n < 2; ++n) { const i32x4 lo_ = *(const LAS i32x4*)(lds + PG8_SB(b, h) + boff + n * 2048), hi_ = *(const LAS i32x4*)(lds + PG8_SB(b, h) + (boff ^ 16) + n * 2048); dst[n] = __builtin_shufflevector(lo_, hi_, 0, 1, 2, 3, 4, 5, 6, 7); } } while (0)
#define PG8_F8(x) (x)
#define PG8_MMA(ai, bj, At, Bt) do { __builtin_amdgcn_s_setprio(1); _Pragma("unroll") for (int m = 0; m < 4; ++m) _Pragma("unroll") for (int n = 0; n < 2; ++n) \
        acc[ai][bj][m][n] = __builtin_amdgcn_mfma_scale_f32_16x16x128_f8f6f4(PG8_F8(Bt[n]), PG8_F8(At[m]), acc[ai][bj][m][n], 0, 0, 0, SCALE_W, 0, 127); __builtin_amdgcn_s_setprio(0); \
        _Pragma("unroll") for (int m = 0; m < 4; ++m) _Pragma("unroll") for (int n = 0; n < 2; ++n) asm volatile("" : "+v"(acc[ai][bj][m][n])); } while (0)
#define PG8_WAIT_V(n) asm volatile("s_waitcnt vmcnt(" #n ")" ::: "memory")
#define PG8_WAIT_L(n) asm volatile("s_waitcnt lgkmcnt(" #n ")" ::: "memory")
#define PG8_BAR __builtin_amdgcn_s_barrier()
#define PG8_SCHED __builtin_amdgcn_sched_barrier(0)
    Unit cur, nxt; int ui = 0;
    if (!S.next(0, cur)) return;
    f32x4 acc[2][2][4][2];
#pragma unroll
    for (int a = 0; a < 2; ++a)
#pragma unroll
        for (int b = 0; b < 2; ++b)
#pragma unroll
            for (int m = 0; m < 4; ++m)
#pragma unroll
                for (int n = 0; n < 2; ++n) acc[a][b][m][n] = (f32x4){0.f, 0.f, 0.f, 0.f};
    i32x8 At[4], B0[2], B1[2];
    const char* cA = cur.a; const char* cB = cur.b;
    if constexpr (GATHER) {
#pragma unroll
        for (int h = 0; h < 2; ++h)
#pragma unroll
            for (int i = 0; i < 2; ++i) { int R, C; stage_rc(tid * 16 + i * 8192, R, C); voffA[h][i] = (unsigned)rows[cur.pm * BM + h * HALF + R] * (unsigned)K + (unsigned)C * 2u; } }
    PG8_STAGE(PG8_SB(0, 0), cB, voffB); PG8_STAGE(PG8_SB(0, 1), cB + hstep, voffB); PG8_STAGE(PG8_SA(0, 0), cA, voffA[0]); PG8_STAGE_A1(PG8_SA(0, 1), cA, voffA);
    if (wr == 1) PG8_BAR;
    PG8_WAIT_V(2); PG8_BAR;
    PG8_STAGE(PG8_SB(1, 0), cB + kstep, voffB); PG8_STAGE(PG8_SA(1, 0), cA + kstep, voffA[0]); PG8_STAGE(PG8_SB(1, 1), cB + hstep + kstep, voffB);
    PG8_WAIT_V(6); PG8_BAR;
    for (;;) {
        const bool has_next = S.next(ui + 1, nxt);
        const char* nA = has_next ? nxt.a : cA; const char* nB = has_next ? nxt.b : cB;
        if constexpr (GATHER) {
            const int npm = has_next ? nxt.pm : cur.pm;
#pragma unroll
            for (int h = 0; h < 2; ++h)
#pragma unroll
                for (int i = 0; i < 2; ++i) { int R, C; stage_rc(tid * 16 + i * 8192, R, C); voffN[h][i] = (unsigned)rows[npm * BM + h * HALF + R] * (unsigned)K + (unsigned)C * 2u; } }
#pragma unroll 1
        for (int t = 0; t < nt; t += 2) {
            const bool last = (t == nt - 2);
            unsigned vs[2][2];
#pragma unroll
            for (int h = 0; h < 2; ++h)
#pragma unroll
                for (int i = 0; i < 2; ++i) { if constexpr (GATHER) vs[h][i] = last ? voffN[h][i] : voffA[h][i]; else vs[h][i] = voffA[h][i]; }
            const char* a1 = cA + (size_t)(t + 1) * kstep;
            const char* a2 = last ? nA : cA + (size_t)(t + 2) * kstep; const char* b2 = last ? nB : cB + (size_t)(t + 2) * kstep;
            const char* a3 = a2 + kstep; const char* b3 = b2 + kstep;
            PG8_LDB(B0, 0, 0); PG8_LDB(B1, 0, 1); PG8_SCHED; PG8_LDA(At, 0, 0); PG8_STAGE_A1(PG8_SA(1, 1), a1, voffA);
            PG8_WAIT_V(8); PG8_WAIT_L(0); PG8_BAR; PG8_MMA(0, 0, At, B0); PG8_MMA(0, 1, At, B1); PG8_BAR; PG8_SCHED;
            PG8_LDA(At, 0, 1); PG8_STAGE(PG8_SB(0, 0), b2, voffB); PG8_STAGE(PG8_SB(0, 1), b2 + hstep, voffB); PG8_STAGE(PG8_SA(0, 0), a2, vs[0]);
            PG8_WAIT_V(8); PG8_WAIT_L(0); PG8_BAR; PG8_MMA(1, 0, At, B0); PG8_MMA(1, 1, At, B1); PG8_BAR; PG8_SCHED;
            PG8_LDB(B0, 1, 0); PG8_LDB(B1, 1, 1); PG8_SCHED; PG8_LDA(At, 1, 0); PG8_STAGE_A1(PG8_SA(0, 1), a2, vs);
            PG8_WAIT_V(8); PG8_WAIT_L(0); PG8_BAR; PG8_MMA(0, 0, At, B0); PG8_MMA(0, 1, At, B1); PG8_BAR; PG8_SCHED;
            PG8_LDA(At, 1, 1); PG8_STAGE(PG8_SB(1, 0), b3, voffB); PG8_STAGE(PG8_SB(1, 1), b3 + hstep, voffB); PG8_STAGE(PG8_SA(1, 0), a3, vs[0]);
            PG8_WAIT_V(8); PG8_WAIT_L(0); PG8_BAR; PG8_MMA(1, 0, At, B0); PG8_MMA(1, 1, At, B1); PG8_BAR; PG8_SCHED;
        }
        if constexpr (ALIGN_EPI) { if (wr == 0) PG8_BAR; }
        E(acc, cur, wr, wc, fr, fq);
        if (!has_next) break;
#pragma unroll
        for (int a = 0; a < 2; ++a)
#pragma unroll
            for (int b = 0; b < 2; ++b)
#pragma unroll
                for (int m = 0; m < 4; ++m)
#pragma unroll
                    for (int n = 0; n < 2; ++n) acc[a][b][m][n] = (f32x4){0.f, 0.f, 0.f, 0.f};
        cur = nxt; cA = nA; cB = nB; ++ui;
        if constexpr (GATHER) {
#pragma unroll
            for (int h = 0; h < 2; ++h)
#pragma unroll
                for (int i = 0; i < 2; ++i) voffA[h][i] = voffN[h][i]; }
        if constexpr (ALIGN_EPI) { if (wr == 1) PG8_BAR; }
    }
    PG8_WAIT_V(0);
    if constexpr (!ALIGN_EPI) { if (wr == 0) PG8_BAR; }
    PG8_BAR;
#undef PG8_SA
#undef PG8_SB
#undef PG8_STAGE
#undef PG8_STAGE_A1
#undef PG8_LDA
#undef PG8_LDB
#undef PG8_MMA
#undef PG8_F8
#undef PG8_WAIT_V
#undef PG8_WAIT_L
#undef PG8_BAR
#undef PG8_SCHED
}
}

struct Args { const float* in[20]; float* out; unsigned char* ws; int ph_lo, ph_hi, sub, pad; };
enum { I_X = 0, I_C, I_WADA, I_BADA, I_G1, I_WIN, I_WCONV, I_BCONV, I_BGATES, I_GHEAD, I_WOUT, I_G2, I_WRG, I_BRG, I_WRE, I_BRE, I_WEG, I_WEU, I_WED, I_GFIN };

struct P0Item { const float* src; bf16_t* dst; int ldw, K, f8; };
__device__ __forceinline__ void p0_item_decode(const Args& a, int it, P0Item& I) {
    unsigned char* ws = a.ws;
    constexpr int I_W1 = 16 * 112, I_WO = 16 * 32, I_EXP = 768;
    int r = it;
    if (r < I_W1) { const int kb = r / 112, nb = r % 112, d0 = 32 * nb; I.f8 = 1; I.ldw = 3592; I.K = 1024; I.src = a.in[I_WIN] + (size_t)(64 * kb) * 3592 + (d0 < 2048 ? d0 : d0 + 8); I.dst = (bf16_t*)(ws + WS_W1T + (size_t)d0 * 1024 + 64 * kb); return; }
    r -= I_W1;
    if (r < I_WO) { const int kb = r / 32, nb = r % 32; I.f8 = 0; I.ldw = 1024; I.K = 1024; I.src = a.in[I_WOUT] + (size_t)(64 * kb) * 1024 + 32 * nb; I.dst = (bf16_t*)(ws + WS_WOT) + (size_t)(32 * nb) * 1024 + 64 * kb; return; }
    r -= I_WO;
    const int e = r / I_EXP; r -= e * I_EXP;
    if (r < 512) { const int up = r >> 8, rr = r & 255, kb = rr / 16, nb = rr % 16, n0 = 32 * nb; I.ldw = 512; I.K = 1024;
        I.src = (up ? a.in[I_WEU] : a.in[I_WEG]) + (size_t)e * 1024 * 512 + (size_t)(64 * kb) * 512 + n0; I.f8 = 1; I.dst = (bf16_t*)(ws + WS_WGU + (size_t)e * 1024 * 1024 + (size_t)((n0 >> 7) * 256 + up * 128 + (n0 & 127)) * 1024 + 64 * kb); }
    else { const int rr = r - 512, kb = rr / 32, nb = rr % 32; I.ldw = 1024; I.K = 512;
        I.src = a.in[I_WED] + (size_t)e * 512 * 1024 + (size_t)(64 * kb) * 1024 + 32 * nb; I.f8 = 1; I.dst = (bf16_t*)(ws + WS_WD + (size_t)e * 1024 * 512 + (size_t)(32 * nb) * 512 + 64 * kb); }
}
__device__ __forceinline__ void p0_item_load(const P0Item& I, int lane, f32x4 (&ld)[8]) {
#pragma unroll
    for (int i = 0; i < 8; ++i) ld[i] = *(const f32x4*)(I.src + (size_t)(8 * i + (lane >> 3)) * I.ldw + 4 * (lane & 7));
}
__device__ __forceinline__ void p0_item_store(const P0Item& I, int lane, const f32x4 (&ld)[8], LAS float* scr) {
#pragma unroll
    for (int i = 0; i < 8; ++i) { LAS float* d = scr + (8 * i + (lane >> 3)) * 33 + 4 * (lane & 7); d[0] = ld[i].x; d[1] = ld[i].y; d[2] = ld[i].z; d[3] = ld[i].w; }
    LDS_WAIT(); asm volatile("" ::: "memory");
    if (I.f8) {
        const int n = lane & 31, hf = lane >> 5; const LAS float* s = scr + (32 * hf) * 33 + n; unsigned w[8];
#pragma unroll
        for (int q = 0; q < 8; ++q) w[q] = pk4_fp8(s[(4 * q) * 33] * 32.0f, s[(4 * q + 1) * 33] * 32.0f, s[(4 * q + 2) * 33] * 32.0f, s[(4 * q + 3) * 33] * 32.0f);
        unsigned char* d = (unsigned char*)I.dst + (size_t)n * I.K + 32 * hf;
        *(u32x4*)d = (u32x4){w[0], w[1], w[2], w[3]}; *(u32x4*)(d + 16) = (u32x4){w[4], w[5], w[6], w[7]};
    } else {
        const int c = lane >> 3;
#pragma unroll
        for (int j = 0; j < 4; ++j) { const int n = (lane & 7) + 8 * j; const LAS float* s = scr + (8 * c) * 33 + n;
            u32x4 o; o.x = pk2(s[0 * 33], s[1 * 33]); o.y = pk2(s[2 * 33], s[3 * 33]); o.z = pk2(s[4 * 33], s[5 * 33]); o.w = pk2(s[6 * 33], s[7 * 33]);
            *(u32x4*)(I.dst + (size_t)n * I.K + 8 * c) = o; }
    }
    LDS_WAIT(); asm volatile("" ::: "memory");
}
__device__ __forceinline__ void phase0(const Args& a, LAS unsigned char* lds, int gw, int NGW, int wave, int lane) {
    unsigned char* ws = a.ws;
    LAS float* scr = (LAS float*)(lds + wave * 16384);
    if (gw < 384) {
        const int g = lane >> 2, q = lane & 3, col0 = 16 * gw + 4 * q;
        const float* wp = a.in[I_WADA] + (size_t)(64 * g) * 6144 + col0;
        float acc[8][4];
#pragma unroll
        for (int b = 0; b < 8; ++b)
#pragma unroll
            for (int e = 0; e < 4; ++e) acc[b][e] = 0.f;
        for (int half = 0; half < 2; ++half) {
            for (int kk = q; kk < 32; kk += 4) {
#pragma unroll
                for (int b = 0; b < 8; ++b) { const float cv = a.in[I_C][b * 1024 + 64 * g + 32 * half + kk]; scr[(g * 8 + b) * 32 + kk] = cv / (1.0f + expf(-cv)); } }
            LDS_WAIT(); asm volatile("" ::: "memory");
            for (int it0 = 0; it0 < 32; it0 += 8) {
                f32x4 w8[8];
#pragma unroll
                for (int u = 0; u < 8; ++u) w8[u] = *(const f32x4*)(wp + (size_t)(32 * half + it0 + u) * 6144);
#pragma unroll
                for (int u = 0; u < 8; ++u)
#pragma unroll
                    for (int b = 0; b < 8; ++b) { const float sv = scr[(g * 8 + b) * 32 + it0 + u];
#pragma unroll
                        for (int e = 0; e < 4; ++e) acc[b][e] += sv * w8[u][e]; } }
            LDS_WAIT(); asm volatile("" ::: "memory");
        }
#pragma unroll
        for (int b = 0; b < 8; ++b)
#pragma unroll
            for (int e = 0; e < 4; ++e) { float v = acc[b][e]; v += __shfl_xor(v, 4); v += __shfl_xor(v, 8); v += __shfl_xor(v, 16); v += __shfl_xor(v, 32); acc[b][e] = v; }
        if (lane < 4) { float* mod = (float*)(ws + WS_MOD); const f32x4 ba = *(const f32x4*)(a.in[I_BADA] + col0);
#pragma unroll
            for (int b = 0; b < 8; ++b) *(f32x4*)(mod + b * 6144 + col0) = (f32x4){acc[b][0] + ba.x, acc[b][1] + ba.y, acc[b][2] + ba.z, acc[b][3] + ba.w}; }
        LDS_WAIT(); asm volatile("" ::: "memory");
    }
    constexpr int NITEMS = 16 * 112 + 16 * 32 + NEXP * 768;
    P0Item cur, nxt; f32x4 ld[8], ldn[8];
    int it = gw;
    if (it < NITEMS) { p0_item_decode(a, it, cur); p0_item_load(cur, lane, ld); }
    for (; it < NITEMS; it += NGW) {
        const bool more = it + NGW < NITEMS;
        if (more) { p0_item_decode(a, it + NGW, nxt); p0_item_load(nxt, lane, ldn); }
        p0_item_store(cur, lane, ld, scr);
        if (more) { cur = nxt;
#pragma unroll
            for (int i = 0; i < 8; ++i) ld[i] = ldn[i]; }
    }
}

__device__ __forceinline__ float tbfly8(const float (&v)[8], int lane) {
    const bool b5 = (lane & 32) != 0, b4 = (lane & 16) != 0, b3 = (lane & 8) != 0;
    float w[4], u[2], t;
#pragma unroll
    for (int i = 0; i < 4; ++i) { const float snd = b5 ? v[i] : v[4 + i], kp = b5 ? v[4 + i] : v[i]; w[i] = kp + __shfl_xor(snd, 32); }
#pragma unroll
    for (int i = 0; i < 2; ++i) { const float snd = b4 ? w[i] : w[2 + i], kp = b4 ? w[2 + i] : w[i]; u[i] = kp + __shfl_xor(snd, 16); }
    { const float snd = b3 ? u[0] : u[1], kp = b3 ? u[1] : u[0]; t = kp + __shfl_xor(snd, 8); }
    t += __shfl_xor(t, 4); t += __shfl_xor(t, 2); t += __shfl_xor(t, 1);
    return t;
}
__device__ __forceinline__ float rdlane(float v, int l) { return __int_as_float(__builtin_amdgcn_readlane(__float_as_int(v), l)); }

__device__ __forceinline__ void p1_rows2(const f32x4 (&x0)[4], const f32x4 (&x1)[4], const f32x4 (&A)[4], const f32x4 (&Bc)[4], const LAS float* wgT, const LAS float* cg, int row, int lane, bf16_t* hn, float* gates) {
    f32x4 t0[4], t1[4]; float ss0 = 0.f, ss1 = 0.f, ga0[8], ga1[8];
#pragma unroll
    for (int g = 0; g < 8; ++g) { ga0[g] = 0.f; ga1[g] = 0.f; }
#pragma unroll
    for (int j = 0; j < 4; ++j) {
        ss0 += (x0[j].x * x0[j].x + x0[j].y * x0[j].y) + (x0[j].z * x0[j].z + x0[j].w * x0[j].w); t0[j] = x0[j] * A[j];
        ss1 += (x1[j].x * x1[j].x + x1[j].y * x1[j].y) + (x1[j].z * x1[j].z + x1[j].w * x1[j].w); t1[j] = x1[j] * A[j];
#pragma unroll
        for (int g = 0; g < 8; ++g) { const f32x4 w = *(const LAS f32x4*)(wgT + g * 1024 + 256 * j + 4 * lane);
            ga0[g] += (t0[j].x * w.x + t0[j].y * w.y) + (t0[j].z * w.z + t0[j].w * w.w); ga1[g] += (t1[j].x * w.x + t1[j].y * w.y) + (t1[j].z * w.z + t1[j].w * w.w); }
        asm volatile("" ::: "memory"); }
    ss0 = wave_sum(ss0); ss1 = wave_sum(ss1);
    const float rstd0 = 1.0f / sqrtf(ss0 * (1.0f / DM) + EPS), rstd1 = 1.0f / sqrtf(ss1 * (1.0f / DM) + EPS);
    const float tot0 = tbfly8(ga0, lane), tot1 = tbfly8(ga1, lane);
#pragma unroll
    for (int j = 0; j < 4; ++j) { const f32x4 h0 = t0[j] * rstd0 + Bc[j], h1 = t1[j] * rstd1 + Bc[j];
        *(unsigned*)((unsigned char*)hn + (size_t)row * DM + 256 * j + 4 * lane) = pk4_fp8(h0.x, h0.y, h0.z, h0.w); *(unsigned*)((unsigned char*)hn + (size_t)(row + 1) * DM + 256 * j + 4 * lane) = pk4_fp8(h1.x, h1.y, h1.z, h1.w); }
    if ((lane & 7) == 0) { const float c = cg[lane >> 3]; gates[(size_t)row * 8 + (lane >> 3)] = tot0 * rstd0 + c; gates[(size_t)(row + 1) * 8 + (lane >> 3)] = tot1 * rstd1 + c; }
}
__device__ __forceinline__ void phase1(const Args& a, LAS unsigned char* lds, int blk, int tid, int wave, int lane) {
    unsigned char* ws = a.ws;
    LAS float* wgT = (LAS float*)lds;
    LAS float* cg = (LAS float*)(lds + 32768);
    for (int idx = tid; idx < 2048; idx += NTHREADS) { const int k = idx >> 1, q = idx & 1; const f32x4 v = *(const f32x4*)(a.in[I_WIN] + (size_t)k * 3592 + 2048 + 4 * q);
        LAS float* d = wgT + (4 * q) * 1024 + k; d[0] = v.x; d[1024] = v.y; d[2048] = v.z; d[3072] = v.w; }
    __syncthreads();
    const int b = blk >> 5; const float* mod = (const float*)(ws + WS_MOD) + b * 6144;
    f32x4 A[4], Bc[4];
#pragma unroll
    for (int j = 0; j < 4; ++j) { const int c0 = 256 * j + 4 * lane; const f32x4 g = *(const f32x4*)(a.in[I_G1] + c0), sc = *(const f32x4*)(mod + 1024 + c0); A[j] = g * (sc + 1.0f); Bc[j] = *(const f32x4*)(mod + c0); }
    { float s = 0.f;
#pragma unroll
      for (int j = 0; j < 4; ++j) { const f32x4 w = *(const LAS f32x4*)(wgT + wave * 1024 + 256 * j + 4 * lane); s += (Bc[j].x * w.x + Bc[j].y * w.y) + (Bc[j].z * w.z + Bc[j].w * w.w); }
      s = wave_sum(s); if (lane == 0) cg[wave] = s + a.in[I_BGATES][wave]; }
    __syncthreads();
    bf16_t* hn = (bf16_t*)(ws + WS_HN); float* gates = (float*)(ws + WS_GATES);
    const float* xb = a.in[I_X] + (size_t)(blk * 256 + wave * 32) * DM + 4 * lane;
    f32x4 nx[2][4];
#pragma unroll
    for (int r = 0; r < 2; ++r)
#pragma unroll
        for (int j = 0; j < 4; ++j) nx[r][j] = *(const f32x4*)(xb + (size_t)r * DM + 256 * j);
    for (int it = 0; it < 16; ++it) {
        f32x4 c0[4], c1[4];
#pragma unroll
        for (int j = 0; j < 4; ++j) { c0[j] = nx[0][j]; c1[j] = nx[1][j]; }
        if (it < 15) {
#pragma unroll
            for (int r = 0; r < 2; ++r)
#pragma unroll
                for (int j = 0; j < 4; ++j) nx[r][j] = *(const f32x4*)(xb + (size_t)(2 * it + 2 + r) * DM + 256 * j); }
        const int row = blk * 256 + wave * 32 + 2 * it;
        p1_rows2(c0, c1, A, Bc, wgT, cg, row, lane, hn, gates);
    }
}

__device__ __forceinline__ void p3_conv_tile(const bf16_t* src  , int tloc0, const float* wconv  , const float* bconv  ,
                                             float scale, bf16_t* dst, LAS unsigned char* scr, int lane) {
    const int rr = lane >> 3, ch = lane & 7;
#pragma unroll
    for (int li = 0; li < 9; ++li) { const int r = 8 * li + rr - 8; const bool ok = (tloc0 + r >= 0); u32x4 v = *(const u32x4*)(src + (ptrdiff_t)(ok ? r : 0) * 64 + 8 * ch); if (!ok) v = (u32x4){0u, 0u, 0u, 0u}; *(LAS u32x4*)(scr + (8 + r) * 144 + 16 * ch) = v; }
    float wc[4][8], bc[8];
#pragma unroll
    for (int j = 0; j < 4; ++j)
#pragma unroll
        for (int e = 0; e < 8; ++e) wc[j][e] = wconv[j * 1024 + 8 * ch + e];
#pragma unroll
    for (int e = 0; e < 8; ++e) bc[e] = bconv[8 * ch + e];
    LDS_WAIT(); asm volatile("" ::: "memory");
#pragma unroll
    for (int i = 0; i < 8; ++i) { const int r = 8 * i + rr; float o[8];
#pragma unroll
        for (int e = 0; e < 8; ++e) o[e] = bc[e];
#pragma unroll
        for (int j = 0; j < 4; ++j) { const u32x4 raw = *(const LAS u32x4*)(scr + (r + 5 + j) * 144 + 16 * ch); float f[8]; unpack8(raw, f);
#pragma unroll
            for (int e = 0; e < 8; ++e) o[e] += wc[j][e] * f[e]; }
#pragma unroll
        for (int e = 0; e < 8; ++e) o[e] = silu_f(o[e]) * scale;
        *(u32x4*)(dst + (size_t)r * 128 + 8 * ch) = (u32x4){pk2(o[0], o[1]), pk2(o[2], o[3]), pk2(o[4], o[5]), pk2(o[6], o[7])}; }
    LDS_WAIT(); asm volatile("" ::: "memory");
}
__device__ __forceinline__ float logsigmoidf_(float x) { return fminf(x, 0.f) - log1pf(expf(-fabsf(x))); }
__device__ __forceinline__ void phase3(const Args& a, LAS unsigned char* lds, int gw, int NGW, int wave, int lane) {
    unsigned char* ws = a.ws; const bf16_t* hm = (const bf16_t*)(ws + WS_QA);
    LAS unsigned char* scr = lds + wave * 16384;
    constexpr int NT3 = 8192;
    for (int it = gw; it < 2 * NT3 + 2048 + 1024; it += NGW) {
        if (it < 2 * NT3) {
            const int type = it / NT3, r = it % NT3, grp = r & 7, tch = (r >> 3) & 127, b = r >> 10, tloc0 = tch * 64;
            const size_t tok0 = (size_t)b * SEQ + tloc0;
            if (type == 0) { const int chan = 512 + grp * 64;
                p3_conv_tile(hm + 4 * HM_SEC + ((size_t)(b * 8 + grp) * SEQ + tloc0) * 64, tloc0, a.in[I_WCONV] + chan, a.in[I_BCONV] + chan, 1.0f, (bf16_t*)(ws + WS_KC) + ((size_t)(b * 4 + (grp >> 1)) * SEQ + tloc0) * 128 + (grp & 1) * 64, scr, lane); }
            else { const int chan = grp * 64;
                p3_conv_tile(hm + 3 * HM_SEC + ((size_t)(b * 8 + grp) * SEQ + tloc0) * 64, tloc0, a.in[I_WCONV] + chan, a.in[I_BCONV] + chan, 0.08838834764831845f, (bf16_t*)(ws + WS_QC) + ((size_t)(b * 4 + (grp >> 1)) * SEQ + tloc0) * 128 + (grp & 1) * 64, scr, lane); }
        } else if (it < 2 * NT3 + 2048) {
            const int r = it - 2 * NT3, h = r & 7, j = (r >> 3) & 31, b = r >> 8; const int rr = lane >> 3, ch = lane & 7;
            const bf16_t* src = (const bf16_t*)(ws + WS_QA) + HM_SEC + ((size_t)(b * 8 + h) * SEQ + j * 256) * 64 + 8 * ch;
            float s[8];
#pragma unroll
            for (int e = 0; e < 8; ++e) s[e] = 0.f;
#pragma unroll 8
            for (int li = 0; li < 32; ++li) { const u32x4 v = *(const u32x4*)(src + (size_t)(8 * li + rr) * 64); float f[8]; unpack8(v, f);
#pragma unroll
                for (int e = 0; e < 8; ++e) s[e] += f[e]; }
#pragma unroll
            for (int e = 0; e < 8; ++e) { float v = s[e]; v += __shfl_xor(v, 8); v += __shfl_xor(v, 16); v += __shfl_xor(v, 32); s[e] = v * (1.0f / 256.0f); }
            if (lane < 8) { float* km = (float*)(ws + WS_KMEAN) + ((size_t)(b * 8 + h) * 32 + j) * 64 + 8 * ch; *(f32x4*)km = (f32x4){s[0], s[1], s[2], s[3]}; *(f32x4*)(km + 4) = (f32x4){s[4], s[5], s[6], s[7]}; }
        } else {
            const int r = it - 2 * NT3 - 2048, sc = r & 31, bh = r >> 5, b = bh >> 2, h = bh & 3;
            const float* gates = (const float*)(ws + WS_GATES) + ((size_t)b * SEQ + sc * 256 + 4 * lane) * 8;
            float lf[4], ip[4];
#pragma unroll
            for (int e = 0; e < 4; ++e) { ip[e] = gates[e * 8 + h]; lf[e] = logsigmoidf_(gates[e * 8 + 4 + h]); }
            lf[1] += lf[0]; lf[2] += lf[1]; lf[3] += lf[2];
            float tot = lf[3], incl = tot;
#pragma unroll
            for (int o = 1; o < 64; o <<= 1) { const float t = __shfl_up(incl, o); if (lane >= o) incl += t; }
            const float excl = incl - tot;
            float av[4], amax = -INFINITY;
#pragma unroll
            for (int e = 0; e < 4; ++e) { lf[e] += excl; av[e] = ip[e] - lf[e]; amax = fmaxf(amax, av[e]); }
            amax = wave_max(amax);
            const size_t o = (size_t)bh * SEQ + sc * 256 + 4 * lane;
            *(f32x4*)((float*)(ws + WS_BCUM) + o) = (f32x4){lf[0], lf[1], lf[2], lf[3]};
            *(f32x4*)((float*)(ws + WS_AVAL) + o) = (f32x4){av[0], av[1], av[2], av[3]};
            const float blast = __shfl(lf[3], 63);
            if (lane == 0) { float* si = (float*)(ws + WS_SCINFO) + (size_t)(bh * 32 + sc) * 4; si[0] = amax; si[1] = blast; }
        }
    }
}

typedef short v4i16_t __attribute__((ext_vector_type(4)));
__device__ __forceinline__ u32x2 tr16(const LAS unsigned char* p) { return __builtin_bit_cast(u32x2, __builtin_amdgcn_ds_read_tr16_b64_v4i16((LAS v4i16_t*)p)); }

constexpr int SA_S = 288;
__device__ __forceinline__ void mlstm_stageA(const Args& a, LAS unsigned char* lds, int vcu, int G, int tid, int wave, int lane) {
    unsigned char* ws = a.ws; const int fr = lane & 15, fq = lane >> 4;
    LAS unsigned char* kt = lds;
    LAS unsigned char* vt = lds + 128 * SA_S;
    LAS float* wts = (LAS float*)(lds + 256 * SA_S);
    const bf16_t* vm = (const bf16_t*)(ws + WS_VM); const bf16_t* kc = (const bf16_t*)(ws + WS_KC);
    const int trow = 4 * fq + (fr >> 2), tcol = 4 * (fr & 3);
    for (int item = vcu; item < 1024; item += G) {
        const int bh = item >> 5, sc = item & 31, b = bh >> 2, h = bh & 3; const size_t tok0 = (size_t)b * SEQ + sc * 256;
        const float* si = (const float*)(ws + WS_SCINFO) + (size_t)item * 4;
        __syncthreads();
        if (tid < 256) wts[tid] = expf(((const float*)(ws + WS_AVAL))[(size_t)bh * SEQ + sc * 256 + tid] - si[0]);
        f32x4 acc[8];
#pragma unroll
        for (int n = 0; n < 8; ++n) acc[n] = (f32x4){0.f, 0.f, 0.f, 0.f};
        f32x4 accn = (f32x4){0.f, 0.f, 0.f, 0.f};
        for (int half = 0; half < 2; ++half) {
            if (half) __syncthreads();
#pragma unroll
            for (int i = 0; i < 4; ++i) { const int p = tid + NTHREADS * i, row = p >> 4, pc = p & 15; const size_t tk = ((size_t)bh * SEQ + sc * 256 + 128 * half + row) * 128 + 8 * pc;
                *(LAS u32x4*)(kt + row * SA_S + 16 * pc) = *(const u32x4*)(kc + tk);
                *(LAS u32x4*)(vt + row * SA_S + 16 * pc) = *(const u32x4*)(vm + tk); }
            __syncthreads();
#pragma unroll
            for (int ks = 0; ks < 4; ++ks) {
                const LAS unsigned char* ap = vt + (32 * ks + trow) * SA_S + (16 * wave + tcol) * 2;
                const u32x2 a0 = tr16(ap), a1 = tr16(ap + 16 * SA_S);
                const f32x4 w0 = *(const LAS f32x4*)(wts + 128 * half + 32 * ks + 4 * fq), w1 = *(const LAS f32x4*)(wts + 128 * half + 32 * ks + 16 + 4 * fq);
                const u32x4 ap4 = (u32x4){pk2(lo16(a0.x) * w0.x, hi16(a0.x) * w0.y), pk2(lo16(a0.y) * w0.z, hi16(a0.y) * w0.w), pk2(lo16(a1.x) * w1.x, hi16(a1.x) * w1.y), pk2(lo16(a1.y) * w1.z, hi16(a1.y) * w1.w)};
                const bf16x8 af = __builtin_bit_cast(bf16x8, ap4);
                const bf16x8 awf = (fr == 0) ? __builtin_bit_cast(bf16x8, (u32x4){pk2(w0.x, w0.y), pk2(w0.z, w0.w), pk2(w1.x, w1.y), pk2(w1.z, w1.w)}) : __builtin_bit_cast(bf16x8, (u32x4){0u, 0u, 0u, 0u});
#pragma unroll
                for (int n = 0; n < 8; ++n) { const LAS unsigned char* bp = kt + (32 * ks + trow) * SA_S + (16 * n + tcol) * 2;
                    const u32x2 b0 = tr16(bp), b1 = tr16(bp + 16 * SA_S); const bf16x8 bfr = __builtin_bit_cast(bf16x8, (u32x4){b0.x, b0.y, b1.x, b1.y});
                    acc[n] = __builtin_amdgcn_mfma_f32_16x16x32_bf16(af, bfr, acc[n], 0, 0, 0); }
                { const LAS unsigned char* bp = kt + (32 * ks + trow) * SA_S + (16 * wave + tcol) * 2; const u32x2 b0 = tr16(bp), b1 = tr16(bp + 16 * SA_S);
                  accn = __builtin_amdgcn_mfma_f32_16x16x32_bf16(awf, __builtin_bit_cast(bf16x8, (u32x4){b0.x, b0.y, b1.x, b1.y}), accn, 0, 0, 0); }
            }
        }
        if (fq == 0) ((float*)(ws + WS_NLOC))[(size_t)item * 128 + 16 * wave + fr] = accn[0];
        float* cl = (float*)(ws + WS_CLOC) + (size_t)item * 16384;
#pragma unroll
        for (int n = 0; n < 8; ++n)
#pragma unroll
            for (int j = 0; j < 4; ++j) cl[(16 * wave + 4 * fq + j) * 128 + 16 * n + fr] = acc[n][j];
    }
}

__device__ __forceinline__ void moba_gate(const Args& a, LAS unsigned char* lds, int blk, int tid, int wave, int lane) {
    unsigned char* ws = a.ws; const int b = blk >> 5, pp = blk & 31, half = pp >> 4;
    LAS float* km = (LAS float*)lds;
    __syncthreads();
    { const float* src = (const float*)(ws + WS_KMEAN) + (size_t)b * 8 * 32 * 64;
      for (int i = tid; i < 4096; i += NTHREADS) *(LAS f32x4*)(km + 4 * i) = *(const f32x4*)(src + 4 * i); }
    __syncthreads();
    const int h = wave;
    for (int r = 0; r < 4; ++r) {
        const int own = (r < 2) ? pp : 31 - pp;
        unsigned* sel = (unsigned*)(ws + WS_SEL) + (size_t)(b * 8 + h) * SEQ + own * 256;
        const int tl = 128 * half + lane + 64 * (r & 1); const bf16_t* qp = (const bf16_t*)(ws + WS_QA) + ((size_t)(b * 8 + h) * SEQ + own * 256 + tl) * 64;
        float q[64];
#pragma unroll
        for (int c = 0; c < 8; ++c) { const u32x4 v = *(const u32x4*)(qp + 8 * c); unpack8(v, q + 8 * c); }
        float b0 = -INFINITY, b1 = -INFINITY, b2 = -INFINITY; unsigned i0 = 0xFFu, i1 = 0xFFu, i2 = 0xFFu;
        for (int j = 0; j < own; ++j) { const LAS float* kp = km + (h * 32 + j) * 64; float d0 = 0.f, d1 = 0.f;
#pragma unroll
            for (int c = 0; c < 16; ++c) { const f32x4 kv = *(const LAS f32x4*)(kp + 4 * c); d0 += q[4 * c] * kv.x + q[4 * c + 2] * kv.z; d1 += q[4 * c + 1] * kv.y + q[4 * c + 3] * kv.w; }
            const float g = d0 + d1;
            if (g > b0) { b2 = b1; i2 = i1; b1 = b0; i1 = i0; b0 = g; i0 = (unsigned)j; }
            else if (g > b1) { b2 = b1; i2 = i1; b1 = g; i1 = (unsigned)j; }
            else if (g > b2) { b2 = g; i2 = (unsigned)j; } }
        sel[tl] = i0 | (i1 << 8) | (i2 << 16) | 0xFF000000u;
    }
}

__device__ __forceinline__ int crow(int r, int hi) { return (r & 3) + 8 * (r >> 2) + 4 * hi; }
constexpr int MB_KS = 144, MB_VS = 192;
constexpr int MB_K = 0, MB_V = 256 * MB_KS, MB_Q = MB_V + 256 * MB_VS, MB_WT = MB_Q + 16384, MB_ST = MB_WT + 64, MB_STS = 144, MB_STW = 32 * MB_STS + 256;
static_assert(MB_ST + 8 * MB_STW <= MISC_OFF, "MoBA LDS map");
constexpr float SM_SCALE_LOG2 = 0.125f * 1.4426950408889634f;
__device__ __forceinline__ void moba_stage_kv(const bf16_t* qkv, int b, int h, int j, LAS unsigned char* lds, int tid) {
    const bf16_t* kp = qkv + HM_SEC + ((size_t)(b * 8 + h) * SEQ + j * 256) * 64;
#pragma unroll
    for (int i = 0; i < 4; ++i) { const int p = tid + NTHREADS * i, row = p >> 3, ch = p & 7;
        { const u32x4 kv = *(const u32x4*)(kp + (size_t)row * 64 + 8 * ch); float f[8]; unpack8(kv, f);
          *(LAS u32x4*)(lds + MB_K + row * MB_KS + 16 * ch) = (u32x4){pk2(f[0] * SM_SCALE_LOG2, f[1] * SM_SCALE_LOG2), pk2(f[2] * SM_SCALE_LOG2, f[3] * SM_SCALE_LOG2), pk2(f[4] * SM_SCALE_LOG2, f[5] * SM_SCALE_LOG2), pk2(f[6] * SM_SCALE_LOG2, f[7] * SM_SCALE_LOG2)}; }
        *(LAS u32x4*)(lds + MB_V + row * MB_VS + 16 * ch) = *(const u32x4*)(kp + HM_SEC + (size_t)row * 64 + 8 * ch); }
}
__device__ __forceinline__ bf16x8 moba_vfrag(const LAS unsigned char* vbase  , int kt, int s2, int d0) {
    const LAS unsigned char* p = vbase + (32 * kt + 16 * s2) * MB_VS + 64 * d0;
    const u32x2 v0 = tr16(p), v1 = tr16(p + 8 * MB_VS);
    return __builtin_bit_cast(bf16x8, (u32x4){v0.x, v0.y, v1.x, v1.y});
}
template <bool DIAG>
__device__ __forceinline__ void moba_wave_attn(LAS unsigned char* lds, const bf16x8 (&qf)[4], int nkt, int qpos, int lane, f32x16 (&o)[2], float& m_out, float& l_out) {
    const int r32 = lane & 31, hi = lane >> 5;
    const LAS unsigned char* vbase = lds + MB_V + (4 * hi + ((lane & 15) >> 2)) * MB_VS + (16 * ((lane >> 4) & 1) + 4 * (lane & 3)) * 2;
    const LAS unsigned char* kbase = lds + MB_K + r32 * MB_KS + 16 * hi;
    float m = -INFINITY, l = 0.f;
    o[0] = f32x16{}; o[1] = f32x16{};
#pragma unroll 1
    for (int kp = 0; 2 * kp < nkt; ++kp) {
        const bool two = (2 * kp + 1 < nkt);
        bf16x8 kf[2][4];
#pragma unroll
        for (int k2 = 0; k2 < 2; ++k2)
#pragma unroll
            for (int d0 = 0; d0 < 4; ++d0) kf[k2][d0] = *(const LAS bf16x8*)(kbase + (32 * (2 * kp + k2)) * MB_KS + 32 * d0);
        LDS_WAIT(); __builtin_amdgcn_sched_barrier(0);
        f32x16 p[2];
#pragma unroll
        for (int k2 = 0; k2 < 2; ++k2) { f32x16 s = {};
#pragma unroll
            for (int d0 = 0; d0 < 4; ++d0) s = __builtin_amdgcn_mfma_f32_32x32x16_bf16(kf[k2][d0], qf[d0], s, 0, 0, 0);
            p[k2] = s; }
        if (!two) {
#pragma unroll
            for (int r = 0; r < 16; ++r) p[1][r] = -INFINITY; }
        if (DIAG) { const int kl = nkt - 1 - 2 * kp;
            if (kl == 0) {
#pragma unroll
                for (int r = 0; r < 16; ++r) if (32 * (2 * kp) + crow(r, hi) > qpos) p[0][r] = -INFINITY; }
            else if (kl == 1) {
#pragma unroll
                for (int r = 0; r < 16; ++r) if (32 * (2 * kp + 1) + crow(r, hi) > qpos) p[1][r] = -INFINITY; } }
        bf16x8 vf[2][2][2];
#pragma unroll
        for (int k2 = 0; k2 < 2; ++k2)
#pragma unroll
            for (int s2 = 0; s2 < 2; ++s2)
#pragma unroll
                for (int d0 = 0; d0 < 2; ++d0) vf[k2][s2][d0] = moba_vfrag(vbase, 2 * kp + k2, s2, d0);
        float tm = p[0][0];
#pragma unroll
        for (int k2 = 0; k2 < 2; ++k2)
#pragma unroll
            for (int r = 0; r < 16; ++r) tm = fmaxf(tm, p[k2][r]);
        tm = fmaxf(tm, __shfl_xor(tm, 32));
        const float mn = fmaxf(m, tm);
        const float alpha = __builtin_amdgcn_exp2f(m - mn);
        float ls = 0.f;
#pragma unroll
        for (int k2 = 0; k2 < 2; ++k2)
#pragma unroll
            for (int r = 0; r < 16; ++r) { const float e = __builtin_amdgcn_exp2f(p[k2][r] - mn); p[k2][r] = e; ls += e; }
        l = l * alpha + ls; m = mn;
#pragma unroll
        for (int r = 0; r < 16; ++r) { o[0][r] *= alpha; o[1][r] *= alpha; }
        bf16x8 pb[2][2];
#pragma unroll
        for (int k2 = 0; k2 < 2; ++k2)
#pragma unroll
            for (int s2 = 0; s2 < 2; ++s2) pb[k2][s2] = __builtin_bit_cast(bf16x8, (u32x4){pk2(p[k2][8 * s2], p[k2][8 * s2 + 1]), pk2(p[k2][8 * s2 + 2], p[k2][8 * s2 + 3]), pk2(p[k2][8 * s2 + 4], p[k2][8 * s2 + 5]), pk2(p[k2][8 * s2 + 6], p[k2][8 * s2 + 7])});
        LDS_WAIT(); __builtin_amdgcn_sched_barrier(0);
#pragma unroll
        for (int k2 = 0; k2 < 2; ++k2)
#pragma unroll
            for (int s2 = 0; s2 < 2; ++s2)
#pragma unroll
                for (int d0 = 0; d0 < 2; ++d0) o[d0] = __builtin_amdgcn_mfma_f32_32x32x16_bf16(vf[k2][s2][d0], pb[k2][s2], o[d0], 0, 0, 0);
    }
    m_out = m; l_out = l + __shfl_xor(l, 32);
}
template <int VAR = 0>
__device__ __forceinline__ void moba_wave_attn_full(LAS unsigned char* lds, const bf16x8 (&qf)[4], int lane, f32x16 (&o)[2], float& m_out, float& l_out) {
    const int r32 = lane & 31, hi = lane >> 5;
    const LAS unsigned char* vbase = lds + MB_V + (4 * hi + ((lane & 15) >> 2)) * MB_VS + (16 * ((lane >> 4) & 1) + 4 * (lane & 3)) * 2;
    const LAS unsigned char* kbase = lds + MB_K + r32 * MB_KS + 16 * hi;
    float l = 0.f;
    o[0] = f32x16{}; o[1] = f32x16{};
    float nm = 0.f;
#pragma unroll
    for (int hg = 0; hg < 2; ++hg) {
        f32x16 p[4];
#pragma unroll
        for (int kp = 0; kp < 2; ++kp) {
            bf16x8 kf[2][4];
#pragma unroll
            for (int k2 = 0; k2 < 2; ++k2)
#pragma unroll
                for (int d0 = 0; d0 < 4; ++d0) kf[k2][d0] = *(const LAS bf16x8*)(kbase + (32 * (4 * hg + 2 * kp + k2)) * MB_KS + 32 * d0);
            LDS_WAIT(); __builtin_amdgcn_sched_barrier(0);
            if (hg == 0 && kp == 0) {
                f32x16 s = {};
#pragma unroll
                for (int d0 = 0; d0 < 4; ++d0) s = __builtin_amdgcn_mfma_f32_32x32x16_bf16(kf[0][d0], qf[d0], s, 0, 0, 0);
                float mx = s[0];
#pragma unroll
                for (int r = 1; r < 16; ++r) mx = fmaxf(mx, s[r]);
                mx = fmaxf(mx, __shfl_xor(mx, 32));
#pragma unroll
                for (int r = 0; r < 16; ++r) s[r] -= mx;
                nm = -mx; m_out = mx; p[0] = s; }
#pragma unroll
            for (int k2 = ((hg == 0 && kp == 0) ? 1 : 0); k2 < 2; ++k2) { f32x16 s;
#pragma unroll
                for (int r = 0; r < 16; ++r) s[r] = nm;
#pragma unroll
                for (int d0 = 0; d0 < 4; ++d0) s = __builtin_amdgcn_mfma_f32_32x32x16_bf16(kf[k2][d0], qf[d0], s, 0, 0, 0);
                p[2 * kp + k2] = s; }
        }
#pragma unroll
        for (int k4 = 0; k4 < 4; ++k4) {
            bf16x8 vf[2][2];
#pragma unroll
            for (int s2 = 0; s2 < 2; ++s2)
#pragma unroll
                for (int d0 = 0; d0 < 2; ++d0) vf[s2][d0] = moba_vfrag(vbase, 4 * hg + k4, s2, d0);
            bf16x8 pb[2];
#pragma unroll
            for (int r = 0; r < 16; ++r) { const float e = (VAR == 2) ? p[k4][r] * 0.001f : __builtin_amdgcn_exp2f(p[k4][r]); p[k4][r] = e; l += e; }
#pragma unroll
            for (int s2 = 0; s2 < 2; ++s2) pb[s2] = __builtin_bit_cast(bf16x8, (u32x4){pk2(p[k4][8 * s2], p[k4][8 * s2 + 1]), pk2(p[k4][8 * s2 + 2], p[k4][8 * s2 + 3]), pk2(p[k4][8 * s2 + 4], p[k4][8 * s2 + 5]), pk2(p[k4][8 * s2 + 6], p[k4][8 * s2 + 7])});
            LDS_WAIT(); __builtin_amdgcn_sched_barrier(0);
#pragma unroll
            for (int s2 = 0; s2 < 2; ++s2)
#pragma unroll
                for (int d0 = 0; d0 < 2; ++d0) o[d0] = __builtin_amdgcn_mfma_f32_32x32x16_bf16(vf[s2][d0], pb[s2], o[d0], 0, 0, 0);
        }
    }
    l_out = l + __shfl_xor(l, 32);
}

template <int VAR = 0>
__device__ __forceinline__ void moba_partial(const Args& a, float* dout, LAS unsigned char* lds, int vcu, int wave) {
    unsigned char* ws = a.ws; const bf16_t* proj = (const bf16_t*)(ws + WS_QA);
    bf16_t* slots = (bf16_t*)((unsigned char*)dout + DO_SLOTS); float* mlb = (float*)((unsigned char*)dout + DO_ML);
    LAS unsigned short* queue = (LAS unsigned short*)(lds + MB_Q);
    LAS unsigned* wtot = (LAS unsigned*)(lds + MB_WT);
    const int bh = vcu >> 2, s4 = vcu & 3, b = bh >> 3, h = bh & 7;
    const unsigned* sel = (const unsigned*)(ws + WS_SEL) + (size_t)bh * SEQ;
    for (int ii = 0; ii < 8; ++ii) {
        const int j = (ii & 1) ? (8 * (ii >> 1) + 7 - s4) : (8 * (ii >> 1) + s4);
        if (j >= 31) continue;
        const int lane = fresh_lane(), tid = wave * 64 + lane, r32 = lane & 31, hi = lane >> 5;
        __syncthreads();
        moba_stage_kv(proj, b, h, j, lds, tid);
        const int tstart = 256 * (j + 1);
        unsigned w[16]; int cnt = 0;
#pragma unroll
        for (int c4 = 0; c4 < 4; ++c4) { const int t = tstart + 16 * tid + 4 * c4; const u32x4 x = *(const u32x4*)(sel + (t < SEQ ? t : SEQ - 4));
            w[4 * c4] = (t < SEQ) ? x.x : 0xFFFFFFFFu; w[4 * c4 + 1] = (t < SEQ) ? x.y : 0xFFFFFFFFu; w[4 * c4 + 2] = (t < SEQ) ? x.z : 0xFFFFFFFFu; w[4 * c4 + 3] = (t < SEQ) ? x.w : 0xFFFFFFFFu; }
#pragma unroll
        for (int ck = 0; ck < 16; ++ck) { const unsigned x = w[ck]; const int slot = ((x & 0xFFu) == (unsigned)j) ? 0 : (((x >> 8) & 0xFFu) == (unsigned)j) ? 1 : (((x >> 16) & 0xFFu) == (unsigned)j) ? 2 : 3; w[ck] = (unsigned)slot; cnt += (slot < 3) ? 1 : 0; }
        int incl = cnt;
#pragma unroll
        for (int o = 1; o < 64; o <<= 1) { const int t = __shfl_up(incl, o); if (lane >= o) incl += t; }
        if (lane == 63) wtot[wave] = (unsigned)incl;
        __syncthreads();
        unsigned base = 0, total = 0;
#pragma unroll
        for (int w8 = 0; w8 < 8; ++w8) { const unsigned c = wtot[w8]; if (w8 < wave) base += c; total += c; }
        unsigned off = base + (unsigned)(incl - cnt);
#pragma unroll
        for (int ck = 0; ck < 16; ++ck) { if (w[ck] < 3u) { queue[off] = (unsigned short)((unsigned)(tstart + 16 * tid + ck) | (w[ck] << 13)); ++off; } }
        __syncthreads();
        unsigned ent_n = (unsigned)tstart; bool val_n = false; bf16x8 qf_n[4];
        { const unsigned avail = total; const bool act = (unsigned)(32 * wave) < avail; val_n = (unsigned)(32 * wave + r32) < avail;
          if (act) { ent_n = (unsigned)queue[val_n ? 32 * wave + r32 : 0]; if (!val_n) ent_n = (unsigned)tstart; const bf16_t* qp = proj + ((size_t)bh * SEQ + (ent_n & 0x1FFFu)) * 64 + 8 * hi;
#pragma unroll
              for (int d0 = 0; d0 < 4; ++d0) qf_n[d0] = *(const bf16x8*)(qp + 16 * d0); } }
        for (unsigned qhead = 0; qhead < ((VAR == 4) ? 0u : total); qhead += 256u) {
            const unsigned avail = total - qhead;
            const bool act = (unsigned)(32 * wave) < avail;
            const unsigned ent = ent_n; const bool valid = val_n; bf16x8 qf[4];
#pragma unroll
            for (int d0 = 0; d0 < 4; ++d0) qf[d0] = qf_n[d0];
            if (avail > 256u) { const unsigned av2 = avail - 256u;
                if ((unsigned)(32 * wave) < av2) { val_n = (unsigned)(32 * wave + r32) < av2; ent_n = (unsigned)queue[val_n ? qhead + 256u + 32 * wave + r32 : 0u]; if (!val_n) ent_n = (unsigned)tstart;
                    const bf16_t* qp = proj + ((size_t)bh * SEQ + (ent_n & 0x1FFFu)) * 64 + 8 * hi;
#pragma unroll
                    for (int d0 = 0; d0 < 4; ++d0) qf_n[d0] = *(const bf16x8*)(qp + 16 * d0); } }
            float m = 0.f, l = 0.f;
            LAS unsigned char* stg = lds + MB_ST + wave * MB_STW;
            if (act) {
                f32x16 o[2];
                if (VAR == 1) { o[0] = f32x16{}; o[1] = f32x16{}; m = 0.f; l = 1.f; asm volatile("" :: "v"(qf[0]), "v"(qf[1]), "v"(qf[2]), "v"(qf[3])); } else
                moba_wave_attn_full<VAR>(lds, qf, lane, o, m, l);
#pragma unroll
                for (int d0 = 0; d0 < 2; ++d0)
#pragma unroll
                    for (int g = 0; g < 4; ++g) *(LAS u32x2*)(stg + r32 * MB_STS + (32 * d0 + 8 * g + 4 * hi) * 2) = (u32x2){pk2(o[d0][4 * g], o[d0][4 * g + 1]), pk2(o[d0][4 * g + 2], o[d0][4 * g + 3])};
            }
#pragma unroll
            for (int d0 = 0; d0 < 4; ++d0) asm volatile("" : "+v"(qf_n[d0]));
            asm volatile("" : "+v"(ent_n));
            if (act) {
                const int t = (int)(ent & 0x1FFFu), slot = (int)(ent >> 13);
                if (VAR != 3 && valid && hi == 0) *(f32x2*)(mlb + (((size_t)bh * SEQ + t) * 3 + slot) * 2) = (f32x2){m, l};
                LDS_WAIT(); asm volatile("" ::: "memory");
#pragma unroll
                for (int i = 0; i < 4; ++i) { const int row = 8 * i + (lane >> 3), ch = lane & 7;
                    if (VAR != 3 && (unsigned)(32 * wave + row) < avail) { const unsigned e2 = queue[qhead + 32 * wave + row]; const int t2 = (int)(e2 & 0x1FFFu), s2 = (int)(e2 >> 13);
                        *(u32x4*)(slots + (((size_t)bh * SEQ + t2) * 3 + s2) * 64 + 8 * ch) = *(const LAS u32x4*)(stg + row * MB_STS + 16 * ch); } }
                LDS_WAIT(); asm volatile("" ::: "memory");
            }
        }
    }
}

__device__ __forceinline__ void moba_own(const Args& a, const float* dout, LAS unsigned char* lds, int vcu, int wave) {
    unsigned char* ws = a.ws; const bf16_t* proj = (const bf16_t*)(ws + WS_QA);
    const bf16_t* slots = (const bf16_t*)((const unsigned char*)dout + DO_SLOTS); const float* mlb = (const float*)((const unsigned char*)dout + DO_ML);
    bf16_t* hcat = (bf16_t*)(ws + WS_HCAT);
    const int b = vcu >> 5, blk = vcu & 31;
    for (int ii = 0; ii < 8; ++ii) {
        const int h = ii, bh = b * 8 + h;
        const unsigned* sel = (const unsigned*)(ws + WS_SEL) + (size_t)bh * SEQ;
        const int lane = fresh_lane(), tid = wave * 64 + lane, r32 = lane & 31, hi = lane >> 5;
        __syncthreads();
        moba_stage_kv(proj, b, h, blk, lds, tid);
        const int tq = blk * 256 + 32 * wave + r32;
        const bf16_t* qp = proj + ((size_t)bh * SEQ + tq) * 64 + 8 * hi;
        bf16x8 qf[4];
#pragma unroll
        for (int d0 = 0; d0 < 4; ++d0) qf[d0] = *(const bf16x8*)(qp + 16 * d0);
        const int ch = lane & 7;
        u32x4 sv[4][3]; f32x2 mls[4][3]; unsigned swv[4];
#pragma unroll
        for (int i = 0; i < 4; ++i) { const int t = blk * 256 + 32 * wave + 8 * i + (lane >> 3); const size_t tg = (size_t)b * SEQ + t; const unsigned sw = sel[t];
#pragma unroll
            for (int s = 0; s < 3; ++s) { const size_t sidx = ((size_t)bh * SEQ + t) * 3 + s;
                mls[i][s] = *(const f32x2*)(mlb + sidx * 2);
                sv[i][s] = *(const u32x4*)(slots + sidx * 64 + 8 * ch); }
            swv[i] = sw; }
        __syncthreads();
        f32x16 o[2]; float m, l;
        moba_wave_attn<true>(lds, qf, wave + 1, 32 * wave + r32, lane, o, m, l);
        LAS unsigned char* stg = lds + MB_ST + wave * MB_STW; LAS float* mst = (LAS float*)(stg + 32 * MB_STS);
#pragma unroll
        for (int d0 = 0; d0 < 2; ++d0)
#pragma unroll
            for (int g = 0; g < 4; ++g) *(LAS u32x2*)(stg + r32 * MB_STS + (32 * d0 + 8 * g + 4 * hi) * 2) = (u32x2){pk2(o[d0][4 * g], o[d0][4 * g + 1]), pk2(o[d0][4 * g + 2], o[d0][4 * g + 3])};
        if (hi == 0) { mst[r32] = m; mst[32 + r32] = l; }
        LDS_WAIT(); asm volatile("" ::: "memory");
#pragma unroll
        for (int i = 0; i < 4; ++i) { const int row = 8 * i + (lane >> 3); const size_t tg = (size_t)b * SEQ + blk * 256 + 32 * wave + row;
            const float mo = mst[row], lo = mst[32 + row];
#pragma unroll
            for (int s = 0; s < 3; ++s) { if (((swv[i] >> (8 * s)) & 0xFFu) == 0xFFu) { mls[i][s] = (f32x2){-INFINITY, 0.f}; sv[i][s] = (u32x4){0u, 0u, 0u, 0u}; } }
            const float M = fmaxf(fmaxf(mo, mls[i][0].x), fmaxf(mls[i][1].x, mls[i][2].x));
            const float w0 = __builtin_amdgcn_exp2f(mo - M); float den = lo * w0;
            float acc[8]; { const u32x4 ov = *(const LAS u32x4*)(stg + row * MB_STS + 16 * ch); unpack8(ov, acc); }
#pragma unroll
            for (int e = 0; e < 8; ++e) acc[e] *= w0;
#pragma unroll
            for (int s = 0; s < 3; ++s) { const float ww = __builtin_amdgcn_exp2f(mls[i][s].x - M); den += mls[i][s].y * ww; float f[8]; unpack8(sv[i][s], f);
#pragma unroll
                for (int e = 0; e < 8; ++e) acc[e] += f[e] * ww; }
            const float inv = 1.0f / den;
            *(u32x4*)(hcat + tg * DM + 512 + h * 64 + 8 * ch) = (u32x4){pk2(acc[0] * inv, acc[1] * inv), pk2(acc[2] * inv, acc[3] * inv), pk2(acc[4] * inv, acc[5] * inv), pk2(acc[6] * inv, acc[7] * inv)}; }
    }
}

__device__ __forceinline__ void mlstm_scan(const Args& a, int blk, int tid) {
    unsigned char* ws = a.ws; const float* scw = (const float*)(ws + WS_SCW);
    const int gid = blk * NTHREADS + tid;
    for (int k = 0; k < 4; ++k) {
        const int elem = gid + 131072 * k, bh = elem >> 14, idx = elem & 16383;
        const float* cl = (const float*)(ws + WS_CLOC) + (size_t)bh * 32 * 16384 + idx; bf16_t* cs = (bf16_t*)(ws + WS_CST) + (size_t)bh * 32 * 16384 + idx;
        float v[32];
#pragma unroll
        for (int sc = 0; sc < 32; ++sc) v[sc] = cl[(size_t)sc * 16384];
        float C = 0.f;
#pragma unroll
        for (int sc = 0; sc < 32; ++sc) { const f32x2 w = *(const f32x2*)(scw + (bh * 32 + sc) * 2);
            cs[(size_t)sc * 16384] = (bf16_t)f2bf(C);
            C = w.x * C + w.y * v[sc]; }
    }
    if (gid < 32 * 128) {
        const int bh = gid >> 7, d = gid & 127; const float* nl = (const float*)(ws + WS_NLOC) + (size_t)bh * 32 * 128 + d; float* ns = (float*)(ws + WS_NST) + (size_t)bh * 32 * 128 + d;
        float v[32];
#pragma unroll
        for (int sc = 0; sc < 32; ++sc) v[sc] = nl[sc * 128];
        float n = 0.f;
#pragma unroll
        for (int sc = 0; sc < 32; ++sc) { const f32x2 w = *(const f32x2*)(scw + (bh * 32 + sc) * 2);
            ns[sc * 128] = n;
            n = w.x * n + w.y * v[sc]; }
    }
}

constexpr int MC_KS = 272, MC_VS = 288;
constexpr int MC_K = 0, MC_V = 256 * MC_KS, MC_A = MC_V + 256 * MC_VS, MC_B = MC_A + 1024, MC_MU = MC_B + 1024, MC_N = MC_MU + 1024, MC_G = MC_N + 512, MC_END = MC_G + 512;
static_assert(MC_END <= MISC_OFF, "stage C LDS map");
__device__ __forceinline__ void mlstm_stageC(const Args& a, LAS unsigned char* lds, int vcu, int G, int wave) {
    unsigned char* ws = a.ws; const bf16_t* vm = (const bf16_t*)(ws + WS_VM); bf16_t* hcat = (bf16_t*)(ws + WS_HCAT);
    const bf16_t* kc = (const bf16_t*)(ws + WS_KC); const bf16_t* qc = (const bf16_t*)(ws + WS_QC);
    LAS float* av = (LAS float*)(lds + MC_A); LAS float* bc = (LAS float*)(lds + MC_B); LAS float* mu = (LAS float*)(lds + MC_MU); LAS float* nst = (LAS float*)(lds + MC_N); LAS float* ghs = (LAS float*)(lds + MC_G);
    for (int kk = 0; kk < 4; ++kk) {
        const int item = ((vcu >> 5) * 4 + kk) * 32 + (vcu & 31);
        const int lane = fresh_lane(), tid = wave * 64 + lane, fr = lane & 15, fq = lane >> 4;
        const LAS unsigned char* vbase = lds + MC_V + (4 * fq + (fr >> 2)) * MC_VS + (4 * (fr & 3)) * 2;
        const int bh = item >> 5, sc = item & 31, b = bh >> 2, h = bh & 3, t0 = sc * 256; const size_t tok0 = (size_t)b * SEQ + t0, hrow0 = (size_t)bh * SEQ + t0;
        const float* si = (const float*)(ws + WS_SCINFO) + (size_t)item * 4; const float mstart = si[2];
        const int tl = tid;
        bf16x8 qf[2][4];
#pragma unroll
        for (int qq = 0; qq < 2; ++qq) { const int tq = 16 * (qq ? (15 - wave) : wave) + fr; const bf16_t* qp = qc + (hrow0 + tq) * 128 + 8 * fq;
#pragma unroll
            for (int ks = 0; ks < 4; ++ks) qf[qq][ks] = *(const bf16x8*)(qp + 32 * ks);
}
        __syncthreads();
        { const bf16_t* cst = (const bf16_t*)(ws + WS_CST) + (size_t)item * 16384;
#pragma unroll
          for (int i = 0; i < 4; ++i) { const int p = tl + NTHREADS * i, row = p >> 4, pc = p & 15; *(LAS u32x4*)(lds + MC_K + row * MC_KS + 16 * pc) = *(const u32x4*)(cst + row * 128 + 8 * pc); } }
#pragma unroll
        for (int i = 0; i < 8; ++i) { const int p = tl + NTHREADS * i, row = p >> 4, pc = p & 15;
            *(LAS u32x4*)(lds + MC_V + row * MC_VS + 16 * pc) = *(const u32x4*)(vm + (hrow0 + row) * 128 + 8 * pc); }
        if (tl >= 64 && tl < 320) { const int t = tl - 64; av[t] = ((const float*)(ws + WS_AVAL))[(size_t)bh * SEQ + t0 + t]; bc[t] = ((const float*)(ws + WS_BCUM))[(size_t)bh * SEQ + t0 + t]; }
        if (tl >= 320 && tl < 448) { nst[tl - 320] = ((const float*)(ws + WS_NST))[(size_t)item * 128 + tl - 320]; ghs[tl - 320] = a.in[I_GHEAD][h * 128 + tl - 320]; }
        if (wave == 0) {
            const f32x4 a4 = *(const f32x4*)((const float*)(ws + WS_AVAL) + (size_t)bh * SEQ + t0 + 4 * lane);
            float x[4]; float run = -INFINITY;
#pragma unroll
            for (int e = 0; e < 4; ++e) { run = fmaxf(run, a4[e]); x[e] = run; }
            float incl = run;
#pragma unroll
            for (int o = 1; o < 64; o <<= 1) { const float t = __shfl_up(incl, o); if (lane >= o) incl = fmaxf(incl, t); }
            float excl = __shfl_up(incl, 1); if (lane == 0) excl = -INFINITY;
#pragma unroll
            for (int e = 0; e < 4; ++e) mu[4 * lane + e] = fmaxf(mstart, fmaxf(excl, x[e]));
        }
        __syncthreads();
        f32x4 acc[2][8]; float qn[2], muq[2], wint[2];
#pragma unroll
        for (int qq = 0; qq < 2; ++qq) { const int tq = 16 * (qq ? (15 - wave) : wave) + fr; muq[qq] = mu[tq]; wint[qq] = fexp(mstart - muq[qq]);
            float s = 0.f;
#pragma unroll
            for (int ks = 0; ks < 4; ++ks) { float f[8]; unpack8(__builtin_bit_cast(u32x4, qf[qq][ks]), f);
#pragma unroll
                for (int e = 0; e < 8; ++e) s += f[e] * nst[32 * ks + 8 * fq + e]; }
            s += __shfl_xor(s, 16); s += __shfl_xor(s, 32); qn[qq] = s; }
#pragma unroll
        for (int m = 0; m < 8; ++m) { f32x4 c0 = (f32x4){0.f, 0.f, 0.f, 0.f}, c1 = c0;
#pragma unroll
            for (int ks = 0; ks < 4; ++ks) { const bf16x8 cf = *(const LAS bf16x8*)(lds + MC_K + (16 * m + fr) * MC_KS + (32 * ks + 8 * fq) * 2);
                c0 = __builtin_amdgcn_mfma_f32_16x16x32_bf16(cf, qf[0][ks], c0, 0, 0, 0); c1 = __builtin_amdgcn_mfma_f32_16x16x32_bf16(cf, qf[1][ks], c1, 0, 0, 0); }
            acc[0][m] = c0 * wint[0]; acc[1][m] = c1 * wint[1]; asm volatile("" : "+v"(acc[0][m]), "+v"(acc[1][m]) :: "memory"); }
        __syncthreads();
#pragma unroll
        for (int i = 0; i < 8; ++i) { const int p = tl + NTHREADS * i, row = p >> 4, pc = p & 15;
            *(LAS u32x4*)(lds + MC_K + row * MC_KS + 16 * pc) = *(const u32x4*)(kc + (hrow0 + row) * 128 + 8 * pc); }
        __syncthreads();
#pragma unroll
        for (int qq = 0; qq < 2; ++qq) {
            const int qt = qq ? (15 - wave) : wave, tq = 16 * qt + fr;
            const float mu_q = muq[qq];
            float den = 0.f;
            for (int g = 0; g <= (qt >> 1); ++g) {
                f32x4 s[2];
#pragma unroll
                for (int j = 0; j < 2; ++j) { f32x4 c = (f32x4){0.f, 0.f, 0.f, 0.f};
#pragma unroll
                    for (int ks = 0; ks < 4; ++ks) { const bf16x8 kf = *(const LAS bf16x8*)(lds + MC_K + (32 * g + 16 * j + fr) * MC_KS + (32 * ks + 8 * fq) * 2); c = __builtin_amdgcn_mfma_f32_16x16x32_bf16(kf, qf[qq][ks], c, 0, 0, 0); }
                    s[j] = c; }
                float pv[8];
#pragma unroll
                for (int j = 0; j < 2; ++j) { const f32x4 a4 = *(const LAS f32x4*)(av + 32 * g + 16 * j + 4 * fq);
#pragma unroll
                    for (int r = 0; r < 4; ++r) { const int key = 32 * g + 16 * j + 4 * fq + r; const float w = (key <= tq) ? fexp(a4[r] - mu_q) : 0.f; const float p = s[j][r] * w; pv[4 * j + r] = p; den += p; } }
                const bf16x8 pb = __builtin_bit_cast(bf16x8, (u32x4){pk2(pv[0], pv[1]), pk2(pv[2], pv[3]), pk2(pv[4], pv[5]), pk2(pv[6], pv[7])});
#pragma unroll
                for (int m = 0; m < 8; ++m) { const LAS unsigned char* vp = vbase + (32 * g) * MC_VS + 32 * m;
                    const u32x2 v0 = tr16(vp), v1 = tr16(vp + 16 * MC_VS);
                    acc[qq][m] = __builtin_amdgcn_mfma_f32_16x16x32_bf16(__builtin_bit_cast(bf16x8, (u32x4){v0.x, v0.y, v1.x, v1.y}), pb, acc[qq][m], 0, 0, 0); if ((m & 3) == 3) asm volatile("" ::: "memory"); }
            }
            den += __shfl_xor(den, 16); den += __shfl_xor(den, 32);
            den += wint[qq] * qn[qq];
            const float flo = fexp(-(bc[tq] + mu_q));
            const float inv = 1.0f / fmaxf(fabsf(den), flo);
            float ss = 0.f;
#pragma unroll
            for (int m = 0; m < 8; ++m) { acc[qq][m] = acc[qq][m] * inv; ss += (acc[qq][m].x * acc[qq][m].x + acc[qq][m].y * acc[qq][m].y) + (acc[qq][m].z * acc[qq][m].z + acc[qq][m].w * acc[qq][m].w); }
            ss += __shfl_xor(ss, 16); ss += __shfl_xor(ss, 32);
            const float rstd = 1.0f / sqrtf(ss * (1.0f / 128.0f) + EPS);
#pragma unroll
            for (int m = 0; m < 8; ++m) acc[qq][m] = acc[qq][m] * rstd;
        }
        __syncthreads();
        { LAS unsigned char* stg = lds + MC_K + wave * (2 * 16 * MC_KS);
#pragma unroll
          for (int qq = 0; qq < 2; ++qq)
#pragma unroll
              for (int m = 0; m < 8; ++m) *(LAS u32x2*)(stg + (qq * 16 + fr) * MC_KS + (16 * m + 4 * fq) * 2) = (u32x2){pk2(acc[qq][m].x, acc[qq][m].y), pk2(acc[qq][m].z, acc[qq][m].w)};
          LDS_WAIT(); asm volatile("" ::: "memory");
          const int ch = lane & 15;
          const f32x4 g0 = *(const LAS f32x4*)(ghs + 8 * ch), g1 = *(const LAS f32x4*)(ghs + 8 * ch + 4);
#pragma unroll
          for (int qq = 0; qq < 2; ++qq) { const int qt = qq ? (15 - wave) : wave;
              u32x4 omv[4];
#pragma unroll
              for (int i = 0; i < 4; ++i) omv[i] = *(const u32x4*)(vm + HM_SEC + (hrow0 + 16 * qt + 4 * i + (lane >> 4)) * 128 + 8 * ch);
#pragma unroll
              for (int i = 0; i < 4; ++i) { const int row = 4 * i + (lane >> 4); float hv[8], ov[8];
                  unpack8(*(const LAS u32x4*)(stg + (qq * 16 + row) * MC_KS + 16 * ch), hv); unpack8(omv[i], ov);
                  const float gg[8] = {g0.x, g0.y, g0.z, g0.w, g1.x, g1.y, g1.z, g1.w}; float r8[8];
#pragma unroll
                  for (int e = 0; e < 8; ++e) r8[e] = hv[e] * gg[e] * __builtin_amdgcn_rcpf(1.0f + fexp(-ov[e]));
                  *(u32x4*)(hcat + (tok0 + 16 * qt + row) * DM + h * 128 + 8 * ch) = (u32x4){pk2(r8[0], r8[1]), pk2(r8[2], r8[3]), pk2(r8[4], r8[5]), pk2(r8[6], r8[7])}; } }
          LDS_WAIT(); asm volatile("" ::: "memory"); }
    }
}

constexpr int P8_WS = 2064;
constexpr int P8_WH = 0, P8_WL = 36 * P8_WS, P8_AV = 2 * 36 * P8_WS, P8_HIST = P8_AV + 4096, P8_CG = P8_HIST + 128;
static_assert(P8_CG + 144 <= MISC_OFF, "phase 8 LDS map");
__device__ __forceinline__ void phase8(const Args& a, LAS unsigned char* lds, int blk, int tid, int wave, int lane) {
    unsigned char* ws = a.ws;
    LAS float* av = (LAS float*)(lds + P8_AV); LAS int* hist = (LAS int*)(lds + P8_HIST); LAS float* cg = (LAS float*)(lds + P8_CG);
    LAS float* red = av;
    const int b = blk >> 5; const float* mod = (const float*)(ws + WS_MOD) + b * 6144;
    __syncthreads();
    { float pe[4] = {0.f, 0.f, 0.f, 0.f}; const int q = tid & 7, g = q >> 1, hf = q & 1;
      for (int i = 0; i < 16; ++i) { const int k = (tid >> 3) + 64 * i; const f32x4 v = *(const f32x4*)(a.in[I_WRE] + (size_t)k * 32 + 4 * q); const float bk = mod[3072 + k];
#pragma unroll
          for (int r = 0; r < 4; ++r) { const float w = v[r]; const unsigned hi = pk2(w, 0.f) & 0xFFFFu; const unsigned lo = pk2(w - bf2f(hi), 0.f) & 0xFFFFu; const int srow = (hf ? 20 : 4) + 4 * g + r;
              *(LAS unsigned short*)(lds + P8_WH + srow * P8_WS + 2 * k) = (unsigned short)hi; *(LAS unsigned short*)(lds + P8_WL + srow * P8_WS + 2 * k) = (unsigned short)lo; pe[r] += bk * w; } }
#pragma unroll
      for (int r = 0; r < 4; ++r) { float v = pe[r]; v += __shfl_xor(v, 8); v += __shfl_xor(v, 16); v += __shfl_xor(v, 32); pe[r] = v; }
      float pg[4] = {0.f, 0.f, 0.f, 0.f};
      for (int i = 0; i < 2; ++i) { const int k = tid + 512 * i; const f32x4 v = *(const f32x4*)(a.in[I_WRG] + (size_t)k * 4); const float bk = mod[3072 + k];
#pragma unroll
          for (int r = 0; r < 4; ++r) { const float w = v[r]; const unsigned hi = pk2(w, 0.f) & 0xFFFFu; const unsigned lo = pk2(w - bf2f(hi), 0.f) & 0xFFFFu;
              *(LAS unsigned short*)(lds + P8_WH + r * P8_WS + 2 * k) = (unsigned short)hi; *(LAS unsigned short*)(lds + P8_WL + r * P8_WS + 2 * k) = (unsigned short)lo; pg[r] += bk * w; } }
#pragma unroll
      for (int r = 0; r < 4; ++r) pg[r] = wave_sum(pg[r]);
      if (lane < 8) {
#pragma unroll
          for (int r = 0; r < 4; ++r) red[wave * 36 + 4 + 4 * lane + r] = pe[r]; }
      if (lane == 0) {
#pragma unroll
          for (int r = 0; r < 4; ++r) red[wave * 36 + r] = pg[r]; }
      if (tid < 32) hist[tid] = 0; }
    __syncthreads();
    if (tid < 36) { float s = 0.f;
#pragma unroll
        for (int w = 0; w < 8; ++w) s += red[w * 36 + tid];
        cg[tid] = s + ((tid < 4) ? a.in[I_BRG][tid] : a.in[I_BRE][tid - 4]); }
    __syncthreads();
    for (int k = tid; k < 1024; k += NTHREADS) av[k] = a.in[I_G2][k] * (1.0f + mod[4096 + k]);
    __syncthreads();
    const int fr = lane & 15, fq = lane >> 4; const int R0 = blk * 256 + wave * 32;
    const bf16_t* x1b = (const bf16_t*)(ws + WS_X1B);
    const bf16_t* xr = x1b + (size_t)(R0 + fr) * DM + 8 * fq;
    const LAS unsigned char* wp0 = lds + (fr & 3) * P8_WS + 16 * fq; const LAS unsigned char* wp1 = lds + (4 + fr) * P8_WS + 16 * fq; const LAS unsigned char* wp2 = lds + (20 + fr) * P8_WS + 16 * fq;
    f32x4 acc[2][3]; float ssq[2] = {0.f, 0.f};
#pragma unroll
    for (int rt = 0; rt < 2; ++rt)
#pragma unroll
        for (int j = 0; j < 3; ++j) acc[rt][j] = (f32x4){0.f, 0.f, 0.f, 0.f};
    u32x4 xc[2][4], xn[2][4];
#pragma unroll
    for (int rt = 0; rt < 2; ++rt)
#pragma unroll
        for (int u = 0; u < 4; ++u) xc[rt][u] = *(const u32x4*)(xr + (size_t)(16 * rt) * DM + 32 * u);
    for (int ks0 = 0; ks0 < 32; ks0 += 4) {
        if (ks0 + 4 < 32) {
#pragma unroll
            for (int rt = 0; rt < 2; ++rt)
#pragma unroll
                for (int u = 0; u < 4; ++u) xn[rt][u] = *(const u32x4*)(xr + (size_t)(16 * rt) * DM + 32 * (ks0 + 4 + u)); }
#pragma unroll
        for (int u = 0; u < 4; ++u) { const int ks = ks0 + u;
            const f32x4 a0 = *(const LAS f32x4*)(av + 32 * ks + 8 * fq), a1 = *(const LAS f32x4*)(av + 32 * ks + 8 * fq + 4);
            bf16x8 wh[3], wl[3];
            wh[0] = *(const LAS bf16x8*)(wp0 + P8_WH + 64 * ks); wh[1] = *(const LAS bf16x8*)(wp1 + P8_WH + 64 * ks); wh[2] = *(const LAS bf16x8*)(wp2 + P8_WH + 64 * ks);
            wl[0] = *(const LAS bf16x8*)(wp0 + P8_WL + 64 * ks); wl[1] = *(const LAS bf16x8*)(wp1 + P8_WL + 64 * ks); wl[2] = *(const LAS bf16x8*)(wp2 + P8_WL + 64 * ks);
#pragma unroll
            for (int rt = 0; rt < 2; ++rt) { float x[8]; unpack8(xc[rt][u], x);
                ssq[rt] += ((x[0] * x[0] + x[1] * x[1]) + (x[2] * x[2] + x[3] * x[3])) + ((x[4] * x[4] + x[5] * x[5]) + (x[6] * x[6] + x[7] * x[7]));
                float t[8] = {x[0] * a0.x, x[1] * a0.y, x[2] * a0.z, x[3] * a0.w, x[4] * a1.x, x[5] * a1.y, x[6] * a1.z, x[7] * a1.w};
                const u32x4 th = (u32x4){pk2(t[0], t[1]), pk2(t[2], t[3]), pk2(t[4], t[5]), pk2(t[6], t[7])}; float hf8[8]; unpack8(th, hf8);
                const u32x4 tl = (u32x4){pk2(t[0] - hf8[0], t[1] - hf8[1]), pk2(t[2] - hf8[2], t[3] - hf8[3]), pk2(t[4] - hf8[4], t[5] - hf8[5]), pk2(t[6] - hf8[6], t[7] - hf8[7])};
                const bf16x8 bh = __builtin_bit_cast(bf16x8, th), bl = __builtin_bit_cast(bf16x8, tl);
#pragma unroll
                for (int j = 0; j < 3; ++j) { f32x4 c = acc[rt][j];
                    c = __builtin_amdgcn_mfma_f32_16x16x32_bf16(wh[j], bh, c, 0, 0, 0); c = __builtin_amdgcn_mfma_f32_16x16x32_bf16(wh[j], bl, c, 0, 0, 0); c = __builtin_amdgcn_mfma_f32_16x16x32_bf16(wl[j], bh, c, 0, 0, 0);
                    acc[rt][j] = c; } } }
#pragma unroll
        for (int rt = 0; rt < 2; ++rt)
#pragma unroll
            for (int u = 0; u < 4; ++u) xc[rt][u] = xn[rt][u];
    }
    int* eid = (int*)(ws + WS_EID); float* ew = (float*)(ws + WS_EW);
    float rstd[2];
#pragma unroll
    for (int rt = 0; rt < 2; ++rt) {
        float ss = ssq[rt]; ss += __shfl_xor(ss, 16); ss += __shfl_xor(ss, 32);
        rstd[rt] = 1.0f / sqrtf(ss * (1.0f / DM) + EPS);
        const f32x4 c4 = *(const LAS f32x4*)cg; float gl[4] = {acc[rt][0][0] * rstd[rt] + c4.x, acc[rt][0][1] * rstd[rt] + c4.y, acc[rt][0][2] * rstd[rt] + c4.z, acc[rt][0][3] * rstd[rt] + c4.w};
        int gi = 0; float gm = gl[0];
#pragma unroll
        for (int g = 1; g < 4; ++g) { const bool gt = gl[g] > gm; gm = gt ? gl[g] : gm; gi = gt ? g : gi; }
        float gs = 0.f;
#pragma unroll
        for (int g = 0; g < 4; ++g) gs += fexp(gl[g] - gm);
        const float gw_ = 1.0f / gs;
        const f32x4 ca = *(const LAS f32x4*)(cg + 4 + fq * 8), cb = *(const LAS f32x4*)(cg + 8 + fq * 8);
        float sv[8] = {acc[rt][1][0] * rstd[rt] + ca.x, acc[rt][1][1] * rstd[rt] + ca.y, acc[rt][1][2] * rstd[rt] + ca.z, acc[rt][1][3] * rstd[rt] + ca.w,
                       acc[rt][2][0] * rstd[rt] + cb.x, acc[rt][2][1] * rstd[rt] + cb.y, acc[rt][2][2] * rstd[rt] + cb.z, acc[rt][2][3] * rstd[rt] + cb.w};
        float t0 = sv[0]; int e0 = 0;
#pragma unroll
        for (int e = 1; e < 8; ++e) { const bool gt = sv[e] > t0; t0 = gt ? sv[e] : t0; e0 = gt ? e : e0; }
        float tt1 = -INFINITY; int e1 = 0;
#pragma unroll
        for (int e = 0; e < 8; ++e) { const bool c = (e != e0) && (sv[e] > tt1); tt1 = c ? sv[e] : tt1; e1 = c ? e : e1; }
        const float p1 = fexp(tt1 - t0), inv = 1.0f / (1.0f + p1);
        if (fq == gi) { const int row = R0 + 16 * rt + fr; *(u32x2*)(eid + row * 2) = (u32x2){(unsigned)(gi * 8 + e0), (unsigned)(gi * 8 + e1)}; *(f32x2*)(ew + row * 2) = (f32x2){inv * gw_, p1 * inv * gw_};
            __hip_atomic_fetch_add(&hist[gi * 8 + e0], 1, __ATOMIC_RELAXED, __HIP_MEMORY_SCOPE_WORKGROUP); __hip_atomic_fetch_add(&hist[gi * 8 + e1], 1, __ATOMIC_RELAXED, __HIP_MEMORY_SCOPE_WORKGROUP); }
    }
    f32x4 A[4], Bc[4];
#pragma unroll
    for (int j = 0; j < 4; ++j) { const int c0 = 256 * j + 4 * lane; const f32x4 g = *(const f32x4*)(a.in[I_G2] + c0), sc = *(const f32x4*)(mod + 4096 + c0); A[j] = g * (sc + 1.0f); Bc[j] = *(const f32x4*)(mod + 3072 + c0); }
    unsigned char* hn = ws + WS_HN2; const bf16_t* xb = x1b + (size_t)R0 * DM + 4 * lane;
    u32x2 bx[3][4];
#define P8_LOAD(S, R) do { _Pragma("unroll") for (int j = 0; j < 4; ++j) bx[S][j] = *(const u32x2*)(xb + (size_t)(R) * DM + 256 * j); } while (0)
#define P8_ROW(S, R) do { const int r_ = (R); const float rs = __shfl((r_ < 16) ? rstd[0] : rstd[1], r_ & 15); \
        _Pragma("unroll") for (int j = 0; j < 4; ++j) { const f32x4 v = (f32x4){lo16(bx[S][j].x), hi16(bx[S][j].x), lo16(bx[S][j].y), hi16(bx[S][j].y)}; const f32x4 h = v * A[j] * rs + Bc[j]; \
            *(unsigned*)(hn + (size_t)(R0 + r_) * DM + 256 * j + 4 * lane) = pk4_fp8(h.x, h.y, h.z, h.w); } } while (0)
    P8_LOAD(0, 0); P8_LOAD(1, 1);
    for (int i = 0; i < 30; i += 3) {
        P8_LOAD(2, i + 2); P8_ROW(0, i);
        P8_LOAD(0, i + 3); P8_ROW(1, i + 1);
        P8_LOAD(1, i + 4); P8_ROW(2, i + 2);
    }
    P8_ROW(0, 30); P8_ROW(1, 31);
#undef P8_LOAD
#undef P8_ROW
    __syncthreads();
    if (tid < 32) ((int*)(ws + WS_BCNT))[blk * 32 + tid] = hist[tid];
}

__device__ __forceinline__ void phase9(const Args& a, LAS unsigned char* lds, int blk, int tid, int wave, int lane) {
    unsigned char* ws = a.ws;
    LAS int* tot = (LAS int*)lds; LAS int* pre = tot + 32; LAS int* pstart = pre + 32;
    LAS int* wcnt = pstart + 40;
    LAS int* posl = wcnt + 256;
    const int* bcnt = (const int*)(ws + WS_BCNT);
    __syncthreads();
    if (tid < 32) { int t = 0, p = 0; for (int c = 0; c < 256; ++c) { const int v = bcnt[c * 32 + tid]; if (c < blk) p += v; t += v; } tot[tid] = t; pre[tid] = p; }
    __syncthreads();
    if (tid == 0) { int run = 0; for (int e = 0; e < 32; ++e) { pstart[e] = run; run += ((tot[e] + 255) >> 8) << 8; } pstart[32] = run; if (blk == 0) *(int*)(ws + WS_NTILES) = run >> 8; }
    __syncthreads();
    if (blk == 0) { const int ntl = pstart[32] >> 8; int* te = (int*)(ws + WS_TILEE);
        for (int rt = tid; rt < ntl; rt += NTHREADS) { int e = 0; for (int k = 1; k < 32; ++k) if (rt * 256 >= pstart[k]) e = k; te[rt] = e; } }
    const int tl = tid >> 1, slot = tid & 1, tok = blk * 256 + tl;
    const int e = ((const int*)(ws + WS_EID))[tok * 2 + slot];
    int myrank = 0;
    for (int k = 0; k < 32; ++k) { const unsigned long long bal = __ballot(e == k); if (e == k) myrank = __popcll(bal & ((1ull << lane) - 1ull)); if (lane == 0) wcnt[wave * 32 + k] = __popcll(bal); }
    __syncthreads();
    int rank = myrank; for (int w = 0; w < wave; ++w) rank += wcnt[w * 32 + e];
    const int pos = pstart[e] + pre[e] + rank;
    ((int*)(ws + WS_POSOF))[tok * 2 + slot] = pos; ((int*)(ws + WS_ROWTOK))[pos] = tok;
    if (blk < 32) { for (int p = pstart[blk] + tot[blk] + tid; p < pstart[blk + 1]; p += NTHREADS) ((int*)(ws + WS_ROWTOK))[p] = 0; }
}

__device__ __forceinline__ f32x4 fp8x4_to_f32(unsigned w) {
    const f32x2 lo = __builtin_amdgcn_cvt_pk_f32_fp8((int)w, false), hi = __builtin_amdgcn_cvt_pk_f32_fp8((int)w, true);
    return (f32x4){lo.x, lo.y, hi.x, hi.y};
}
__device__ __forceinline__ void phase12(const Args& a, float* out, bool with_ffn, int blk, int wave, int lane) {
    unsigned char* ws = a.ws; const int b = blk >> 5; const float* mod = (const float*)(ws + WS_MOD) + b * 6144 + 5120;
    f32x4 G2[4], GF[4];
#pragma unroll
    for (int j = 0; j < 4; ++j) { const int c0 = 256 * j + 4 * lane; G2[j] = *(const f32x4*)(mod + c0); GF[j] = *(const f32x4*)(a.in[I_GFIN] + c0); }
    const unsigned char* ys = ws + WS_YS; const int* posof = (const int*)(ws + WS_POSOF); const float* ew = (const float*)(ws + WS_EW);
    const int row0 = blk * 256 + wave * 32;
    const u32x2 pp = *(const u32x2*)(posof + (size_t)(row0 + (lane & 31)) * 2); const f32x2 ww = *(const f32x2*)(ew + (size_t)(row0 + (lane & 31)) * 2);
    const bf16_t* xb = (const bf16_t*)(ws + WS_X1B) + (size_t)row0 * DM + 4 * lane;
    float* ob = out + (size_t)row0 * DM + 4 * lane;
    u32x2 bx[3][4]; unsigned by0[3][4], by1[3][4];
#define P12_LOAD(S, R) do { const int r_ = (R); const int p0_ = __shfl((int)pp.x, r_), p1_ = __shfl((int)pp.y, r_); \
        _Pragma("unroll") for (int j = 0; j < 4; ++j) { bx[S][j] = *(const u32x2*)(xb + (size_t)r_ * DM + 256 * j); by0[S][j] = *(const unsigned*)(ys + (size_t)p0_ * DM + 256 * j + 4 * lane); by1[S][j] = *(const unsigned*)(ys + (size_t)p1_ * DM + 256 * j + 4 * lane); } } while (0)
#define P12_ROW(S, R) do { const int r_ = (R); const float w0 = __shfl(ww.x, r_), w1 = __shfl(ww.y, r_); f32x4 v[4]; float ss = 0.f; \
        _Pragma("unroll") for (int j = 0; j < 4; ++j) { v[j] = (f32x4){lo16(bx[S][j].x), hi16(bx[S][j].x), lo16(bx[S][j].y), hi16(bx[S][j].y)}; \
            if (with_ffn) v[j] += G2[j] * (fp8x4_to_f32(by0[S][j]) * w0 + fp8x4_to_f32(by1[S][j]) * w1); \
            ss += (v[j].x * v[j].x + v[j].y * v[j].y) + (v[j].z * v[j].z + v[j].w * v[j].w); } \
        ss = wave_sum(ss); const float rstd = 1.0f / sqrtf(ss * (1.0f / DM) + EPS); \
        _Pragma("unroll") for (int j = 0; j < 4; ++j) *(f32x4*)(ob + (size_t)r_ * DM + 256 * j) = v[j] * rstd * GF[j]; } while (0)
    P12_LOAD(0, 0); P12_LOAD(1, 1);
    for (int i = 0; i < 30; i += 3) {
        P12_LOAD(2, i + 2); P12_ROW(0, i);
        P12_LOAD(0, i + 3); P12_ROW(1, i + 1);
        P12_LOAD(1, i + 4); P12_ROW(2, i + 2);
    }
    P12_ROW(0, 30); P12_ROW(1, 31);
#undef P12_LOAD
#undef P12_ROW
}

constexpr int NPHASES = 13;
__global__ void __launch_bounds__(NTHREADS, 2) fwd_kernel(Args args) {
    extern __shared__ __attribute__((aligned(16))) unsigned char lds_raw[];
    LAS unsigned char* lds = (LAS unsigned char*)lds_raw;
    volatile LAS unsigned* MISC = (volatile LAS unsigned*)(lds + MISC_OFF);
    const int wave = __builtin_amdgcn_readfirstlane((int)threadIdx.x >> 6);
#define lane fresh_lane()
#define tid (wave * 64 + fresh_lane())
    const int G = gridDim.x, blk = blockIdx.x;
    const int vcu = (G % 8 == 0) ? (blk % 8) * (G / 8) + blk / 8 : blk;
    const int gw = vcu * NWAVES + wave, NGW = G * NWAVES;
    unsigned char* ws = args.ws;
    if (threadIdx.x < 32) MISC[threadIdx.x] = 0u;
    __syncthreads();
    const int lo = args.ph_lo, hi = args.ph_hi;
    const int sub_lo = args.sub;
#define SUBM ((lo == PH_CUR) ? sub_lo : 3)
    const bool one_launch = (hi - lo) > 1;
    XcdBarrier bar; bar.bar = (unsigned*)(ws + WS_CTL) + CW_BAR; bar.x = 0; bar.st = nullptr;
    if (one_launch) bar = xcd_barrier_post((unsigned*)(ws + WS_CTL) + CW_BAR, MISC + 8);
#ifndef PHASE_MASK
#define PHASE_MASK 0x1FFF
#endif
#define IN(k) ((((PHASE_MASK) >> (k)) & 1) && lo <= (k) && (k) < hi)
#define SEAM(k) do { if (IN(k) && IN((k) + 1)) xcd_barrier(bar, wave == 0 && fresh_lane() == 0); } while (0)

    if (IN(0)) { phase0(args, lds, gw, NGW, wave, lane); } SEAM(0);
    if (IN(1)) { for (int r = vcu; r < 256; r += G) phase1(args, lds, r, tid, wave, lane); } SEAM(1);
    if (IN(2)) {
        pg8::DenseOrder S; S.init(ws + WS_HN, ws + WS_W1T, NTOK, NPROJ, 512, G, blk);
        pg8::EpiProj E{(bf16_t*)(ws + WS_QA), (bf16_t*)(ws + WS_VM)};
        pg8::gemm_phase_fp8<1024, pg8::EpiProj, pg8::DenseOrder, true, false, 122>(lds, S, E, wave, nullptr);
    } SEAM(2);
    if (IN(3)) { phase3(args, lds, gw, NGW, wave, lane); } SEAM(3);
#define PH_CUR 4
    if (IN(4)) {
        const int t4 = tid;
        if (blk == G - 1 && t4 < 32) {
            const float* si = (const float*)(ws + WS_SCINFO) + (size_t)t4 * 32 * 4; float* so = (float*)(ws + WS_SCINFO) + (size_t)t4 * 32 * 4; float* sw = (float*)(ws + WS_SCW) + (size_t)t4 * 32 * 2;
            f32x2 ab[32];
#pragma unroll
            for (int sc = 0; sc < 32; ++sc) ab[sc] = *(const f32x2*)(si + sc * 4);
            float m = 0.f;
#pragma unroll
            for (int sc = 0; sc < 32; ++sc) { const float amax = ab[sc].x, blast = ab[sc].y; so[sc * 4 + 2] = m; const float mu = fmaxf(m, amax); *(f32x2*)(sw + sc * 2) = (f32x2){fexp(m - mu), fexp(amax - mu)}; m = blast + mu; }
        }
        if (SUBM & 1) mlstm_stageA(args, lds, vcu, G, tid, wave, lane);
        if (SUBM & 2) for (int r = vcu; r < 256; r += G) moba_gate(args, lds, r, tid, wave, lane); } SEAM(4);
#undef PH_CUR
#define PH_CUR 5
    if (IN(5)) { if (SUBM & 1) for (int r = blk; r < 256; r += G) mlstm_scan(args, r, tid); if (SUBM & 2) {
#ifdef PROBE_VAR
            if (args.pad == PROBE_VAR) { for (int r = vcu; r < 256; r += G) moba_partial<PROBE_VAR>(args, args.out, lds, r, wave); } else
#endif
            for (int r = vcu; r < 256; r += G) moba_partial<0>(args, args.out, lds, r, wave); } } SEAM(5);
#undef PH_CUR
#define PH_CUR 6
    if (IN(6)) {
        if (SUBM & 1) mlstm_stageC(args, lds, vcu, G, wave);
        if (SUBM & 2) for (int r = vcu; r < 256; r += G) moba_own(args, args.out, lds, r, wave);
    }
#define LOCAL_SEAM(k) do { if (IN(k) && IN((k) + 1)) { asm volatile("s_waitcnt vmcnt(0)" ::: "memory"); __syncthreads(); __builtin_amdgcn_fence(__ATOMIC_ACQUIRE, "agent"); asm volatile("s_waitcnt vmcnt(0)" ::: "memory"); __syncthreads(); } } while (0)
    LOCAL_SEAM(6);
    if (IN(7)) {
        __syncthreads();
        pg8::RowMajorOrder S; S.init(ws + WS_HCAT, ws + WS_WOT, NTOK, DM, 1024, G, vcu);
        pg8::EpiRes E{args.in[I_X], (bf16_t*)(ws + WS_X1B), (const float*)(ws + WS_MOD) + 2048};
        pg8::gemm_phase<1024, pg8::EpiRes, pg8::RowMajorOrder, true>(lds, S, E, wave);
    } LOCAL_SEAM(7);
    if (IN(8)) { for (int r = vcu; r < 256; r += G) phase8(args, lds, r, tid, wave, lane); } SEAM(8);
    if (IN(9)) { for (int r = vcu; r < 256; r += G) phase9(args, lds, r, tid, wave, lane); } SEAM(9);
    if (IN(10)) {
        __syncthreads();
        const int ntl = *(const int*)(ws + WS_NTILES);
        pg8::MoeOrder S{(const int*)(ws + WS_TILEE), ntl * 4, G, vcu, (const char*)(ws + WS_HN2), (const char*)(ws + WS_WGU), (size_t)0, (size_t)1024 * 1024, (size_t)256 * 1024};
        pg8::EpiSwigluF8 E{ws + WS_HB};
        pg8::gemm_phase_fp8<1024, pg8::EpiSwigluF8, pg8::MoeOrder, true, true, 122>(lds, S, E, wave, (const int*)(ws + WS_ROWTOK));
    } SEAM(10);
    if (IN(11)) {
        const int ntl = *(const int*)(ws + WS_NTILES);
        pg8::MoeOrder S{(const int*)(ws + WS_TILEE), ntl * 4, G, vcu, (const char*)(ws + WS_HB), (const char*)(ws + WS_WD), (size_t)256 * 512, (size_t)1024 * 512, (size_t)256 * 512};
        pg8::EpiF8 E{ws + WS_YS, DM};
        pg8::gemm_phase_fp8<512, pg8::EpiF8, pg8::MoeOrder, true, false, 122>(lds, S, E, wave, nullptr);
    } SEAM(11);
    if (IN(12)) { for (int r = vcu; r < 256; r += G) phase12(args, args.out, true, r, wave, lane); }
#undef IN
#undef SEAM
#undef LOCAL_SEAM
#undef lane
#undef tid
}

#ifndef MK_PER_PHASE
#define MK_PER_PHASE 0
#endif
extern "C" void kernel_launch(void* const* d_in, const int* in_sizes, int n_in, void* d_out, int out_size, void* d_ws, size_t ws_size, hipStream_t stream) {
    static int grid = 0;
    if (grid == 0) {
        if (n_in != 20 || out_size != NTOK * DM || ws_size < WS_END) { fprintf(stderr, "kernel_launch: unexpected shapes (n_in %d out %d ws %zu)\n", n_in, out_size, ws_size); grid = -1; return; }
        int dev = 0, cus = 0, per_cu = 0;
        if (hipGetDevice(&dev) != hipSuccess || hipDeviceGetAttribute(&cus, hipDeviceAttributeMultiprocessorCount, dev) != hipSuccess) { grid = -1; return; }
        if (hipFuncSetAttribute((const void*)fwd_kernel, hipFuncAttributeMaxDynamicSharedMemorySize, LDS_BYTES) != hipSuccess) { fprintf(stderr, "kernel_launch: hipFuncSetAttribute failed\n"); grid = -1; return; }
        if (hipOccupancyMaxActiveBlocksPerMultiprocessor(&per_cu, (const void*)fwd_kernel, NTHREADS, LDS_BYTES) != hipSuccess || per_cu < 1) { fprintf(stderr, "kernel_launch: occupancy query says %d\n", per_cu); (void)hipGetLastError(); }
        grid = cus;
        if (grid > 256) grid = 256;
    }
    if (grid < 0) return;
    (void)hipMemsetAsync((char*)d_ws + WS_CTL, 0, CTL_ZERO_BYTES, stream);
    Args a{};
    for (int i = 0; i < 20; ++i) a.in[i] = (const float*)d_in[i];
    a.out = (float*)d_out; a.ws = (unsigned char*)d_ws;
#if MK_PER_PHASE
    a.sub = 3;
    for (int p = 0; p < NPHASES; ++p) { a.ph_lo = p; a.ph_hi = p + 1; hipLaunchKernelGGL(fwd_kernel, dim3(grid), dim3(NTHREADS), LDS_BYTES, stream, a); }
#else
#ifdef PROBE_REPEAT
#ifndef PROBE_SUB
#define PROBE_SUB 3
#endif
    a.ph_lo = 0; a.ph_hi = PROBE_REPEAT + 1; a.sub = 3;
#ifdef PROBE_VAR
    a.pad = PROBE_VAR;
#endif
    { void* kargs[] = {(void*)&a}; (void)hipLaunchCooperativeKernel((const void*)fwd_kernel, dim3(grid), dim3(NTHREADS), kargs, LDS_BYTES, stream); }
    (void)hipMemsetAsync((char*)d_ws + WS_CTL, 0, CTL_ZERO_BYTES, stream);
    a.ph_lo = PROBE_REPEAT; a.ph_hi = NPHASES; a.sub = PROBE_SUB; a.pad = 0;
    { void* kargs[] = {(void*)&a}; (void)hipLaunchCooperativeKernel((const void*)fwd_kernel, dim3(grid), dim3(NTHREADS), kargs, LDS_BYTES, stream); }
#else
    a.ph_lo = 0; a.ph_hi = NPHASES; a.sub = 3;
    void* kargs[] = {(void*)&a};
    hipError_t e = hipLaunchCooperativeKernel((const void*)fwd_kernel, dim3(grid), dim3(NTHREADS), kargs, LDS_BYTES, stream);
    if (e != hipSuccess) { fprintf(stderr, "kernel_launch: cooperative launch failed: %s\n", hipGetErrorString(e)); (void)hipGetLastError();
        hipLaunchKernelGGL(fwd_kernel, dim3(grid), dim3(NTHREADS), LDS_BYTES, stream, a); }
#endif
#endif
}
```
